# Optimizing an MI355X kernel written in HIP

```python
import jax, jax.numpy as jnp
from jax import lax
import numpy as np

D_MODEL = 2048
BATCH = 4
SEQ = 4096
DEPTH = 2

RW_HEAD = 64
RW_WIDTH = D_MODEL
RW_HEADS = RW_WIDTH // RW_HEAD
RW_DECAY_LORA = 96
RW_AAA_LORA = 96
RW_MV_LORA = 64
RW_GATE_LORA = 256
RW_GN_EPS = RW_HEAD * 1e-5
GM_WIDTH = D_MODEL
GM_CHUNK = 128
GM_GROUP = 128
GM_GROUPS = GM_WIDTH // GM_GROUP
NSA_HEADS = 16
NSA_KV_GROUPS = 4
NSA_HPG = NSA_HEADS // NSA_KV_GROUPS
NSA_DK = 192
NSA_DV = 128
NSA_WIDTH = NSA_HEADS * NSA_DV
CMP_BLK = 32
CMP_STRIDE = 16
SEL_BLK = 64
N_SEL = 16
WIN = 512
Q_BLK = 32
D_FF = 5632
N_BRANCH = 3
BRANCH_WIDTH = D_MODEL
ALPHA = (2 * DEPTH) ** 0.25
BETA = (8 * DEPTH) ** -0.25
LN_EPS = 1e-5
NEG = -1e30
FORCED = 1e6

RW_COLS = 3 * RW_WIDTH + RW_DECAY_LORA + RW_AAA_LORA + RW_GATE_LORA
GM_COLS = 2 * GM_WIDTH
NSA_Q_COLS = NSA_HEADS * NSA_DK
NSA_GK = NSA_KV_GROUPS * NSA_DK
NSA_GV = NSA_KV_GROUPS * NSA_DV
NSA_KV_COLS = 3 * (NSA_GK + NSA_GV)
NSA_G_COLS = 3 * NSA_HEADS
NSA_COLS = NSA_Q_COLS + NSA_KV_COLS + NSA_G_COLS
GATE_COLS = N_BRANCH * D_MODEL
OFF_GM = RW_COLS
OFF_NSA = OFF_GM + GM_COLS
OFF_GATE = OFF_NSA + NSA_COLS
C_IN = OFF_GATE + GATE_COLS

kernel_name = 'hybrid_rwkv7_gmlp_nsa_macaron_deepnorm'


def layer_norm(x, g, b):
    xf = x.astype(jnp.float32)
    mu = jnp.mean(xf, -1, keepdims=True)
    var = jnp.mean(jnp.square(xf - mu), -1, keepdims=True)
    return ((xf - mu) * lax.rsqrt(var + LN_EPS) * g + b).astype(x.dtype)


def masked_softmax(s, mask):
    s = jnp.where(mask, s.astype(jnp.float32), NEG)
    e = jnp.where(mask, jnp.exp(s - jnp.max(s, -1, keepdims=True)), 0.0)
    return e / jnp.maximum(jnp.sum(e, -1, keepdims=True), 1e-30)


def swiglu(x, wg, wu, wd):
    return (jax.nn.silu(x @ wg) * (x @ wu)) @ wd


def wkv7_scan(r, w, k, v, a, b):
    B, T, H, N = r.shape

    def step(S, inp):
        r_t, w_t, k_t, v_t, a_t, b_t = inp
        sa = jnp.einsum('bhij,bhj->bhi', S, a_t)
        S = S * w_t[:, :, None, :] + sa[..., None] * b_t[:, :, None, :] + v_t[..., None] * k_t[:, :, None, :]
        return S, jnp.einsum('bhij,bhj->bhi', S, r_t)

    xs = [jnp.moveaxis(z, 1, 0) for z in (r, w, k, v, a, b)]
    _, y = lax.scan(step, jnp.zeros((B, H, N, N), jnp.float32), xs)
    return jnp.moveaxis(y, 0, 1)


def rwkv7_mix(p, v_first, vres, mu, w0, w2, a0, a2, g2, k_k, k_a, r_k, gn_g, gn_b):
    B, T, _ = p.shape
    prev = jnp.pad(p, ((0, 0), (1, 0), (0, 0)))[:, :-1]
    p = p + (prev - p) * mu
    cut = [RW_WIDTH, 2 * RW_WIDTH, 3 * RW_WIDTH, 3 * RW_WIDTH + RW_DECAY_LORA,
           3 * RW_WIDTH + RW_DECAY_LORA + RW_AAA_LORA]
    r, k, v, wl, al, gl = jnp.split(p, cut, axis=-1)
    w = -jax.nn.softplus(-(w0 + jnp.tanh(wl) @ w2)) - 0.5
    a = jax.nn.sigmoid(a0 + al @ a2)
    g = jax.nn.sigmoid(gl) @ g2
    if vres is None:
        v_first = v
    else:
        v0, v1, v2 = vres
        v = v + (v_first - v) * jax.nn.sigmoid(v0 + (v @ v1) @ v2)

    def hs(z):
        return z.reshape(B, T, RW_HEADS, RW_HEAD).astype(jnp.float32)

    kk = hs(k * k_k)
    kk = kk * lax.rsqrt(jnp.maximum(jnp.sum(jnp.square(kk), -1, keepdims=True), 1e-24))
    k = k * (1.0 + (a - 1.0) * k_a)
    rh, kh, vh, ah = hs(r), hs(k), hs(v), hs(a)
    decay = jnp.exp(-jnp.exp(hs(w)))
    y = wkv7_scan(rh, decay, kh, vh, -kk, kk * ah)
    m = jnp.mean(y, -1, keepdims=True)
    var = jnp.mean(jnp.square(y - m), -1, keepdims=True)
    y = ((y - m) * lax.rsqrt(var + RW_GN_EPS)).reshape(B, T, RW_WIDTH) * gn_g + gn_b
    bonus = jnp.sum(rh * kh * r_k, -1, keepdims=True) * vh
    y = (y + bonus.reshape(B, T, RW_WIDTH)) * g
    return y.astype(p.dtype), v_first


def gmlp_mix(p, ln_g, ln_b, ws, bs):
    B, T, _ = p.shape
    u, v = jnp.split(jax.nn.gelu(p), 2, axis=-1)
    v = layer_norm(v, ln_g, ln_b).reshape(B, T // GM_CHUNK, GM_CHUNK, GM_GROUPS, GM_GROUP)
    causal = jnp.tril(jnp.ones((GM_CHUNK, GM_CHUNK), ws.dtype))
    s = jnp.einsum('gts,bcsgd->bctgd', ws * causal, v) + bs.T[None, None, :, :, None]
    return u * s.reshape(B, T, GM_WIDTH)


def compress(z, pos, w1, w2):
    B, T, G, d = z.shape
    n_c = (T - CMP_BLK) // CMP_STRIDE + 1
    idx = np.arange(n_c)[:, None] * CMP_STRIDE + np.arange(CMP_BLK)[None, :]
    blocks = z[:, idx] + pos[None, None, :, None, :]
    flat = blocks.transpose(0, 3, 1, 2, 4).reshape(B, G, n_c, CMP_BLK * d)
    return jax.nn.gelu(flat @ w1) @ w2


def nsa_mix(p, pos_k, pos_v, phi_k1, phi_k2, phi_v1, phi_v2):
    B, T, _ = p.shape
    G, h = NSA_KV_GROUPS, NSA_HPG
    q = p[..., :NSA_Q_COLS].reshape(B, T, G, h, NSA_DK).transpose(0, 2, 3, 1, 4)
    kv = p[..., NSA_Q_COLS:NSA_Q_COLS + NSA_KV_COLS]
    cut = [NSA_GK, NSA_GK + NSA_GV, 2 * NSA_GK + NSA_GV, 2 * NSA_GK + 2 * NSA_GV, 3 * NSA_GK + 2 * NSA_GV]
    kc, vc, ks, vs, kw, vw = jnp.split(kv, cut, axis=-1)
    gates = jax.nn.sigmoid(p[..., NSA_Q_COLS + NSA_KV_COLS:]).reshape(B, T, G, h, 3).transpose(0, 2, 3, 1, 4)

    k_cmp = compress(kc.reshape(B, T, G, NSA_DK), pos_k, phi_k1, phi_k2)
    v_cmp = compress(vc.reshape(B, T, G, NSA_DV), pos_v, phi_v1, phi_v2)
    n_c = k_cmp.shape[2]
    n_s = T // SEL_BLK
    k_sel = min(N_SEL, n_s)
    ks_blk = ks.reshape(B, T, G, NSA_DK).transpose(0, 2, 1, 3).reshape(B, G, n_s, SEL_BLK, NSA_DK)
    vs_blk = vs.reshape(B, T, G, NSA_DV).transpose(0, 2, 1, 3).reshape(B, G, n_s, SEL_BLK, NSA_DV)
    pad = ((0, 0), (0, 0), (WIN, 0), (0, 0))
    kw_pad = jnp.pad(kw.reshape(B, T, G, NSA_DK).transpose(0, 2, 1, 3), pad)
    vw_pad = jnp.pad(vw.reshape(B, T, G, NSA_DV).transpose(0, 2, 1, 3), pad)

    cmp_start = jnp.arange(n_c) * CMP_STRIDE
    cmp_end = cmp_start + CMP_BLK - 1
    blk = jnp.arange(n_s)
    sel_start = blk * SEL_BLK
    overlap = ((cmp_start[:, None] < sel_start[None, :] + SEL_BLK)
               & (cmp_end[:, None] >= sel_start[None, :])).astype(jnp.float32)
    bi = jnp.arange(B)[:, None, None, None]
    gi = jnp.arange(G)[None, :, None, None]
    scale = NSA_DK ** -0.5

    def block(i):
        t0 = i * Q_BLK
        tq = t0 + jnp.arange(Q_BLK)
        qb = lax.dynamic_slice_in_dim(q, t0, Q_BLK, axis=3)
        gb = lax.dynamic_slice_in_dim(gates, t0, Q_BLK, axis=3)
        s_c = jnp.einsum('bghqd,bgnd->bghqn', qb, k_cmp) * scale
        p_c = masked_softmax(s_c, cmp_end[None, :] <= tq[:, None])
        o_c = jnp.einsum('bghqn,bgnd->bghqd', p_c, v_cmp)
        imp = jnp.einsum('bghqn,ns->bgqs', p_c, overlap)
        valid = sel_start[None, :] <= tq[:, None]
        cur = (tq // SEL_BLK)[:, None]
        forced = valid & ((blk[None, :] == 0) | (blk[None, :] == cur) | (blk[None, :] == cur - 1))
        score = jnp.where(forced, FORCED, jnp.where(valid, imp, NEG))
        top_val, top_idx = lax.top_k(score, k_sel)
        sel_ok = top_val > 0.5 * NEG
        kg = ks_blk[bi, gi, top_idx]
        vg = vs_blk[bi, gi, top_idx]
        s_s = jnp.einsum('bghqd,bgqkld->bghqkl', qb, kg) * scale
        kpos = top_idx[..., None] * SEL_BLK + jnp.arange(SEL_BLK)
        m_s = sel_ok[..., None] & (kpos <= tq[:, None, None])
        p_s = masked_softmax(s_s.reshape(B, G, h, Q_BLK, k_sel * SEL_BLK),
                             m_s.reshape(B, G, 1, Q_BLK, k_sel * SEL_BLK)).reshape(s_s.shape)
        o_s = jnp.einsum('bghqkl,bgqkld->bghqd', p_s, vg)
        kwb = lax.dynamic_slice_in_dim(kw_pad, t0, Q_BLK + WIN, axis=2)
        vwb = lax.dynamic_slice_in_dim(vw_pad, t0, Q_BLK + WIN, axis=2)
        kpos_w = t0 - WIN + jnp.arange(Q_BLK + WIN)
        m_w = ((kpos_w[None, :] <= tq[:, None]) & (kpos_w[None, :] > tq[:, None] - WIN)
               & (kpos_w[None, :] >= 0))
        s_w = jnp.einsum('bghqd,bgkd->bghqk', qb, kwb) * scale
        o_w = jnp.einsum('bghqk,bgkd->bghqd', masked_softmax(s_w, m_w), vwb)
        return gb[..., 0:1] * o_c + gb[..., 1:2] * o_s + gb[..., 2:3] * o_w

    out = lax.map(block, jnp.arange(T // Q_BLK))
    return out.transpose(1, 0, 4, 2, 3, 5).reshape(B, T, NSA_WIDTH).astype(p.dtype)


def setup_inputs(seed: int = 0) -> dict:
    key = jax.random.key(seed)
    ks = iter(jax.random.split(key, 48))
    L, D = DEPTH, D_MODEL

    def nrm(shape, scale):
        return jax.random.normal(next(ks), shape, jnp.float32) * scale

    ramp = (jnp.arange(RW_WIDTH, dtype=jnp.float32) / (RW_WIDTH - 1)) ** 0.85
    return {
        'x': nrm((BATCH, SEQ, D), 1.0),
        'w_in': nrm((L, D, C_IN), D ** -0.5),
        'rw_mu': jax.random.uniform(next(ks), (L, RW_COLS), jnp.float32),
        'rw_w0': -6.0 + 5.0 * ramp + nrm((L, RW_WIDTH), 0.1),
        'rw_w2': nrm((L, RW_DECAY_LORA, RW_WIDTH), 0.5 * RW_DECAY_LORA ** -0.5),
        'rw_a0': nrm((L, RW_WIDTH), 0.1),
        'rw_a2': nrm((L, RW_AAA_LORA, RW_WIDTH), RW_AAA_LORA ** -0.5),
        'rw_g2': nrm((L, RW_GATE_LORA, RW_WIDTH), RW_GATE_LORA ** -0.5),
        'rw_v0': nrm((L - 1, RW_WIDTH), 0.1),
        'rw_v1': nrm((L - 1, RW_WIDTH, RW_MV_LORA), RW_WIDTH ** -0.5),
        'rw_v2': nrm((L - 1, RW_MV_LORA, RW_WIDTH), RW_MV_LORA ** -0.5),
        'rw_k_k': 0.85 + nrm((L, RW_WIDTH), 0.05),
        'rw_k_a': 1.0 + nrm((L, RW_WIDTH), 0.05),
        'rw_r_k': nrm((L, RW_HEADS, RW_HEAD), 0.1),
        'rw_gn_g': 1.0 + nrm((L, RW_WIDTH), 0.02),
        'rw_gn_b': nrm((L, RW_WIDTH), 0.02),
        'gm_ln_g': 1.0 + nrm((L, GM_WIDTH), 0.02),
        'gm_ln_b': nrm((L, GM_WIDTH), 0.02),
        'gm_ws': nrm((L, GM_GROUPS, GM_CHUNK, GM_CHUNK), GM_CHUNK ** -0.5),
        'gm_bs': 1.0 + nrm((L, GM_GROUPS, GM_CHUNK), 0.02),
        'nsa_pos_k': nrm((L, CMP_BLK, NSA_DK), 0.02),
        'nsa_pos_v': nrm((L, CMP_BLK, NSA_DV), 0.02),
        'nsa_phi_k1': nrm((L, CMP_BLK * NSA_DK, NSA_DK), (CMP_BLK * NSA_DK) ** -0.5),
        'nsa_phi_k2': nrm((L, NSA_DK, NSA_DK), NSA_DK ** -0.5),
        'nsa_phi_v1': nrm((L, CMP_BLK * NSA_DV, NSA_DV), (CMP_BLK * NSA_DV) ** -0.5),
        'nsa_phi_v2': nrm((L, NSA_DV, NSA_DV), NSA_DV ** -0.5),
        'w_br': nrm((L, N_BRANCH, BRANCH_WIDTH, D), BRANCH_WIDTH ** -0.5),
        'w_o': nrm((L, D, D), BETA * D ** -0.5),
        'ffn1_wg': nrm((L, D, D_FF), D ** -0.5),
        'ffn1_wu': nrm((L, D, D_FF), D ** -0.5),
        'ffn1_wd': nrm((L, D_FF, D), BETA * D_FF ** -0.5),
        'ffn2_wg': nrm((L, D, D_FF), D ** -0.5),
        'ffn2_wu': nrm((L, D, D_FF), D ** -0.5),
        'ffn2_wd': nrm((L, D_FF, D), BETA * D_FF ** -0.5),
        'ln_g': 1.0 + nrm((L, 3, D), 0.02),
        'ln_b': nrm((L, 3, D), 0.02),
    }


def reference(x, w_in, rw_mu, rw_w0, rw_w2, rw_a0, rw_a2, rw_g2, rw_v0, rw_v1, rw_v2,
              rw_k_k, rw_k_a, rw_r_k, rw_gn_g, rw_gn_b, gm_ln_g, gm_ln_b, gm_ws, gm_bs,
              nsa_pos_k, nsa_pos_v, nsa_phi_k1, nsa_phi_k2, nsa_phi_v1, nsa_phi_v2,
              w_br, w_o, ffn1_wg, ffn1_wu, ffn1_wd, ffn2_wg, ffn2_wu, ffn2_wd, ln_g, ln_b):
    B, T, D = x.shape
    v_first = None
    for l in range(DEPTH):
        x = layer_norm(ALPHA * x + 0.5 * swiglu(x, ffn1_wg[l], ffn1_wu[l], ffn1_wd[l]), ln_g[l, 0], ln_b[l, 0])
        wl = w_in[l]
        vres = None if l == 0 else (rw_v0[l - 1], rw_v1[l - 1], rw_v2[l - 1])
        y_rw, v_first = rwkv7_mix(x @ wl[:, :OFF_GM], v_first, vres, rw_mu[l], rw_w0[l], rw_w2[l],
                                  rw_a0[l], rw_a2[l], rw_g2[l], rw_k_k[l], rw_k_a[l], rw_r_k[l],
                                  rw_gn_g[l], rw_gn_b[l])
        y_gm = gmlp_mix(x @ wl[:, OFF_GM:OFF_NSA], gm_ln_g[l], gm_ln_b[l], gm_ws[l], gm_bs[l])
        y_ns = nsa_mix(x @ wl[:, OFF_NSA:OFF_GATE], nsa_pos_k[l], nsa_pos_v[l], nsa_phi_k1[l],
                       nsa_phi_k2[l], nsa_phi_v1[l], nsa_phi_v2[l])
        gate = jax.nn.sigmoid(x @ wl[:, OFF_GATE:]).reshape(B, T, N_BRANCH, D)
        merged = (gate[:, :, 0] * (y_rw @ w_br[l, 0]) + gate[:, :, 1] * (y_gm @ w_br[l, 1])
                  + gate[:, :, 2] * (y_ns @ w_br[l, 2]))
        x = layer_norm(ALPHA * x + merged @ w_o[l], ln_g[l, 1], ln_b[l, 1])
        x = layer_norm(ALPHA * x + 0.5 * swiglu(x, ffn2_wg[l], ffn2_wu[l], ffn2_wd[l]), ln_g[l, 2], ln_b[l, 2])
    return x
```

```cpp
#include <hip/hip_runtime.h>
#include <cstdio>
#include <cstdint>

#define LAS __attribute__((address_space(3)))
#define GAS __attribute__((address_space(1)))
typedef unsigned short bf16;
typedef short bf16x8 __attribute__((ext_vector_type(8)));
typedef float f32x4 __attribute__((ext_vector_type(4)));
typedef float f32x2 __attribute__((ext_vector_type(2)));
typedef unsigned u32x4 __attribute__((ext_vector_type(4)));
typedef unsigned u32x2 __attribute__((ext_vector_type(2)));
typedef GAS unsigned gu32;

constexpr int NB = 4, T = 4096, D = 2048, M = NB * T, FF = 5632, DEPTH = 2;
constexpr int C_IN = 23792;
constexpr float ALPHA = 1.41421356237f;
constexpr float LN_EPS = 1e-5f;
constexpr int NWAVES = 8, NTHR = 512;

constexpr int RING_BYTES = 131072;
constexpr int LDSCTL_OFF = RING_BYTES, MISC_OFF = LDSCTL_OFF + 320;
constexpr int LDS_BYTES = 147456;

constexpr size_t MiB = 1u << 20;
constexpr size_t alup(size_t x) { return (x + 4095) & ~(size_t)4095; }
constexpr size_t WS_CTL = 0, CTL_ZERO_BYTES = 1 * MiB;
constexpr size_t SZ_W1U = (size_t)2 * FF * D * 2, SZ_W1D = (size_t)D * FF * 2, SZ_WIN = (size_t)23808 * D * 2, SZ_DD = (size_t)D * D * 2;
constexpr size_t WS_W1U = 1 * MiB;
constexpr size_t WS_W1D = WS_W1U + SZ_W1U;
constexpr size_t WS_W2U = WS_W1D + SZ_W1D;
constexpr size_t WS_W2D = WS_W2U + SZ_W1U;
constexpr size_t WS_WIN = WS_W2D + SZ_W1D;
constexpr size_t WS_WBR = WS_WIN + SZ_WIN;
constexpr size_t WS_WO  = WS_WBR + 3 * SZ_DD;
constexpr size_t WS_LWA = WS_WO + SZ_DD;
constexpr size_t WS_LG2 = WS_LWA + 4096 * 256 * 2;
constexpr size_t WS_LV1 = WS_LG2 + 2048 * 256 * 2;
constexpr size_t WS_LV2 = WS_LV1 + 256 * 2048 * 2;
constexpr size_t WS_PK1 = WS_LV2 + 2048 * 256 * 2;
constexpr size_t WS_PK2 = WS_PK1 + 256 * 6144 * 2;
constexpr size_t WS_PV1 = WS_PK2 + 256 * 256 * 2;
constexpr size_t WS_PV2 = WS_PV1 + 256 * 4096 * 2;
constexpr size_t WS_WEND = WS_PV2 + 256 * 256 * 2;
constexpr size_t SZ_MD2 = (size_t)M * D * 2, SZ_MD4 = (size_t)M * D * 4;
constexpr size_t WS_XB  = alup(WS_WEND);
constexpr size_t WS_VS0 = WS_XB + SZ_MD2;
constexpr size_t WS_YRW = WS_VS0 + SZ_MD2;
constexpr size_t WS_YGM = WS_YRW + SZ_MD2;
constexpr size_t WS_YNS = WS_YGM + SZ_MD2;
constexpr size_t WS_ARENA = WS_YNS + SZ_MD2;
constexpr size_t WS_H   = WS_ARENA;
constexpr size_t WS_LG  = WS_ARENA;
constexpr size_t WS_RKV = WS_LG + (size_t)M * 512 * 4;
constexpr size_t WS_R2  = WS_RKV + (size_t)M * 6144 * 2;
constexpr size_t WS_GU   = WS_R2;
constexpr size_t WS_QB   = WS_GU + (size_t)M * 4096 * 2;
constexpr size_t SZ_K1   = (size_t)16 * T * 192 * 2;
constexpr size_t WS_K3   = WS_QB + (size_t)M * 3072 * 2;
constexpr size_t WS_VC   = WS_K3 + 3 * SZ_K1;
constexpr size_t WS_VT   = WS_VC + (size_t)16 * T * 128 * 2 + 65536;
constexpr size_t WS_HK   = WS_VT + (size_t)1024 * M * 2;
constexpr size_t WS_HV   = WS_HK + 4096 * 256 * 2;
constexpr size_t WS_KCMP = WS_HV + 4096 * 256 * 2;
constexpr size_t WS_VCMT = WS_KCMP + 4096 * 192 * 2;
constexpr size_t WS_GST  = WS_VCMT + 128 * 4096 * 2;
constexpr size_t WS_YN   = WS_GST + (size_t)M * 8;
constexpr size_t WS_R2A_END = WS_YN + SZ_MD4;
constexpr size_t WS_AL   = WS_R2;
constexpr size_t WS_VS1  = WS_AL + (size_t)M * 512 * 2;
constexpr size_t WS_VL   = WS_VS1 + SZ_MD2;
constexpr size_t WS_DEC  = WS_VL + (size_t)M * 256 * 2;
constexpr size_t WS_AG   = WS_DEC + SZ_MD4;
constexpr size_t WS_GG   = WS_AG + SZ_MD2;
constexpr size_t WS_YR   = WS_GG + SZ_MD2;
constexpr size_t WS_BON  = WS_YR + SZ_MD4;
static_assert(WS_VL + (size_t)M * 256 * 2 <= WS_QB, "A_L / VS1 / VL must stay inside GU (dead during the attention phase)");
constexpr size_t WS_R2B_END = WS_BON + (size_t)M * 32 * 4;
constexpr size_t WS_G    = WS_R2B_END;
constexpr size_t WS_M32  = WS_R2;
constexpr size_t WS_MB   = WS_R2;
constexpr size_t WS_R2C_END = WS_G + (size_t)M * 6144 * 2;
constexpr size_t cmax(size_t a, size_t b) { return a > b ? a : b; }
constexpr size_t WS_END = cmax(cmax(WS_R2A_END, WS_R2B_END), cmax(WS_R2C_END, WS_H + (size_t)M * FF * 2));
constexpr size_t WS_LNS = 640 * 1024;
constexpr size_t WS_B1 = 512 * 1024;

constexpr int CW_TMO = 0, CW_BAR = 4096;

__device__ __forceinline__ unsigned f2bf(float f) { unsigned u = __builtin_bit_cast(unsigned, f); return (u + 0x7fffu + ((u >> 16) & 1u)) >> 16; }
typedef __bf16 hwbf2 __attribute__((ext_vector_type(2)));
__device__ __forceinline__ unsigned pk2h(float lo, float hi) { const f32x2 v = {lo, hi}; const hwbf2 b = __builtin_convertvector(v, hwbf2); return __builtin_bit_cast(unsigned, b); }
__device__ __forceinline__ unsigned pk2(float lo, float hi) { return pk2h(lo, hi); }
__device__ __forceinline__ float bf2f(unsigned short b) { return __builtin_bit_cast(float, ((unsigned)b) << 16); }
__device__ __forceinline__ float bflo(unsigned w) { return __builtin_bit_cast(float, w << 16); }
__device__ __forceinline__ float bfhi(unsigned w) { return __builtin_bit_cast(float, w & 0xffff0000u); }
#define LDS_WAIT() asm volatile("s_waitcnt lgkmcnt(0)" ::: "memory")
#define VM_WAIT() asm volatile("s_waitcnt vmcnt(0)" ::: "memory")

__device__ __forceinline__ int opaque_tid() { int t = threadIdx.x; asm volatile("" : "+v"(t)); return t; }
__device__ __forceinline__ int opaque_s(int x) { asm volatile("" : "+s"(x)); return x; }
namespace pg8 {
constexpr int BM = 256, BK = 64, HALF = 128, HTB = HALF * BK * 2, STAGE_BYTES = 8 * HTB, NXCD = 8, WGM = 4;
__host__ __device__ __forceinline__ int lds_byte(int r, int c) { const int st = (r >> 4) * 2 + (c >> 5), rr = r & 15, cc = c & 31, ob = rr * 64 + cc * 2; return st * 1024 + (ob ^ (((ob >> 9) & 1) << 5)); }
__host__ __device__ __forceinline__ void stage_rc(int b, int& R, int& C) { const int st = b / 1024, sb = b % 1024, swz = sb ^ (((sb >> 9) & 1) << 5); R = (st >> 1) * 16 + swz / 64; C = (st & 1) * 32 + (swz % 64) / 2; }
__host__ __device__ __forceinline__ int perm32(int rho) { const int n = rho >> 4, i = rho & 15; return 8 * (i >> 2) + 4 * n + (i & 3); }
struct Unit { int pm, pn; };
struct Gemm { const bf16* A; const bf16* Bt; int M, N, K, lda, ldb; };
struct StaticOrder {
    int nM, nN, nwg, G, c;
    __host__ __device__ void init(int M_, int N_, int G_, int c_) { nM = M_ / BM; nN = N_ / BM; nwg = nM * nN; G = G_; c = c_; }
    __host__ __device__ bool next(int i, Unit& u) const {
        const long L = (long)i * G + c; if (L >= nwg) return false;
        int wgid = (int)L; { const int q = nwg / NXCD, r = nwg % NXCD, xcd = wgid % NXCD, off = wgid / NXCD; wgid = (xcd < r ? xcd * (q + 1) : r * (q + 1) + (xcd - r) * q) + off; }
        const int nig = WGM * nN, gid = wgid / nig, fm = gid * WGM, gsz = (nM - fm) < WGM ? (nM - fm) : WGM;
        u.pm = fm + ((wgid % nig) % gsz); u.pn = (wgid % nig) / gsz; return true;
    }
};
template <class Epi>
__device__ __forceinline__ void gemm_phase(LAS unsigned char* lds, const Gemm g, const StaticOrder& S, const Epi& E, int wid, int lane_in) {
    const int lane = lane_in, tid = wid * 64 + lane, wr = wid >> 2, wc = wid & 3, fr = lane & 15, fq = lane >> 4;
    const int K = g.K, nt = K / BK;
    unsigned voffA[2], voffB[2];
#pragma unroll
    for (int i = 0; i < 2; ++i) { int R, C; stage_rc(tid * 16 + i * 8192, R, C); const int Rb = (R & ~31) + perm32(R & 31);
        voffA[i] = (unsigned)(R * g.lda + C) * 2u; voffB[i] = (unsigned)(Rb * g.ldb + C) * 2u; }
    const size_t kstep = (size_t)(BK * 2);
    const size_t hstepA = (size_t)HALF * g.lda * 2, hstepB = (size_t)HALF * g.ldb * 2;
    const size_t tstepA = 2 * hstepA, tstepB = 2 * hstepB;
    const unsigned ldsw = (unsigned)wid * 1024u;
    const int aoff = lds_byte(wr * 64 + fr, fq * 8), boff = lds_byte(wc * 32 + fr, fq * 8);
#define PG8_SA(b, h) (((b) * 2 + (h)) * HTB)
#define PG8_SB(b, h) ((4 + (b) * 2 + (h)) * HTB)
#define PG8_STAGE(bufoff, gbase, voff) do { _Pragma("unroll") for (int _i = 0; _i < 2; ++_i) \
        __builtin_amdgcn_global_load_lds((const unsigned*)((const char*)(gbase) + (voff)[_i]), (LAS unsigned*)(lds + (bufoff) + ldsw + _i * 8192), 16, 0, 0); } while (0)
#define PG8_LDA(dst, b, h) do { _Pragma("unroll") for (int m = 0; m < 4; ++m) _Pragma("unroll") for (int k = 0; k < 2; ++k) dst[m][k] = *(const LAS bf16x8*)(lds + PG8_SA(b, h) + aoff + m * 2048 + k * 1024); } while (0)
#define PG8_LDB(dst, b, h) do { _Pragma("unroll") for (int n = 0; n < 2; ++n) _Pragma("unroll") for (int k = 0; k < 2; ++k) dst[n][k] = *(const LAS bf16x8*)(lds + PG8_SB(b, h) + boff + n * 2048 + k * 1024); } while (0)
#define PG8_MMA(ai, bj, At, Bt) do { __builtin_amdgcn_s_setprio(1); _Pragma("unroll") for (int m = 0; m < 4; ++m) _Pragma("unroll") for (int n = 0; n < 2; ++n) _Pragma("unroll") for (int k = 0; k < 2; ++k) \
        acc[ai][bj][m][n] = __builtin_amdgcn_mfma_f32_16x16x32_bf16(Bt[n][k], At[m][k], acc[ai][bj][m][n], 0, 0, 0); __builtin_amdgcn_s_setprio(0); } while (0)
#define PG8_WAIT_V(n) asm volatile("s_waitcnt vmcnt(" #n ")" ::: "memory")
#define PG8_WAIT_L(n) asm volatile("s_waitcnt lgkmcnt(" #n ")" ::: "memory")
#define PG8_BAR __builtin_amdgcn_s_barrier()
#define PG8_SCHED __builtin_amdgcn_sched_barrier(0)
    Unit cur, nxt; int ui = 0;
    if (!S.next(0, cur)) return;
    f32x4 acc[2][2][4][2];
#pragma unroll
    for (int a = 0; a < 2; ++a)
#pragma unroll
        for (int b = 0; b < 2; ++b)
#pragma unroll
            for (int m = 0; m < 4; ++m)
#pragma unroll
                for (int n = 0; n < 2; ++n) acc[a][b][m][n] = (f32x4){0.f, 0.f, 0.f, 0.f};
    bf16x8 At[4][2], B0[2][2], B1[2][2];
    const char* cA = (const char*)g.A + (size_t)cur.pm * tstepA; const char* cB = (const char*)g.Bt + (size_t)cur.pn * tstepB;
    PG8_STAGE(PG8_SB(0, 0), cB, voffB); PG8_STAGE(PG8_SB(0, 1), cB + hstepB, voffB); PG8_STAGE(PG8_SA(0, 0), cA, voffA); PG8_STAGE(PG8_SA(0, 1), cA + hstepA, voffA);
    if (wr == 1) PG8_BAR;
    PG8_WAIT_V(2); PG8_BAR;
    PG8_STAGE(PG8_SB(1, 0), cB + kstep, voffB); PG8_STAGE(PG8_SA(1, 0), cA + kstep, voffA); PG8_STAGE(PG8_SB(1, 1), cB + hstepB + kstep, voffB);
    PG8_WAIT_V(6); PG8_BAR;
    for (;;) {
        const bool has_next = S.next(ui + 1, nxt);
        const char* nA = has_next ? (const char*)g.A + (size_t)nxt.pm * tstepA : cA; const char* nB = has_next ? (const char*)g.Bt + (size_t)nxt.pn * tstepB : cB;
        for (int t = 0; t < nt; t += 2) {
            const bool last = (t == nt - 2);
            const char* a1 = cA + (size_t)(t + 1) * kstep;
            const char* a2 = last ? nA : cA + (size_t)(t + 2) * kstep; const char* b2 = last ? nB : cB + (size_t)(t + 2) * kstep;
            const char* a3 = a2 + kstep; const char* b3 = b2 + kstep;
            PG8_LDB(B0, 0, 0); PG8_LDB(B1, 0, 1); PG8_SCHED; PG8_LDA(At, 0, 0); PG8_STAGE(PG8_SA(1, 1), a1 + hstepA, voffA);
            PG8_WAIT_V(8); PG8_WAIT_L(0); PG8_BAR; PG8_MMA(0, 0, At, B0); PG8_MMA(0, 1, At, B1); PG8_BAR; PG8_SCHED;
            PG8_LDA(At, 0, 1); PG8_STAGE(PG8_SB(0, 0), b2, voffB); PG8_STAGE(PG8_SB(0, 1), b2 + hstepB, voffB); PG8_STAGE(PG8_SA(0, 0), a2, voffA);
            PG8_WAIT_V(8); PG8_WAIT_L(0); PG8_BAR; PG8_MMA(1, 0, At, B0); PG8_MMA(1, 1, At, B1); PG8_BAR; PG8_SCHED;
            PG8_LDB(B0, 1, 0); PG8_LDB(B1, 1, 1); PG8_SCHED; PG8_LDA(At, 1, 0); PG8_STAGE(PG8_SA(0, 1), a2 + hstepA, voffA);
            PG8_WAIT_V(8); PG8_WAIT_L(0); PG8_BAR; PG8_MMA(0, 0, At, B0); PG8_MMA(0, 1, At, B1); PG8_BAR; PG8_SCHED;
            PG8_LDA(At, 1, 1); PG8_STAGE(PG8_SB(1, 0), b3, voffB); PG8_STAGE(PG8_SB(1, 1), b3 + hstepB, voffB); PG8_STAGE(PG8_SA(1, 0), a3, voffA);
            PG8_WAIT_V(8); PG8_WAIT_L(0); PG8_BAR; PG8_MMA(1, 0, At, B0); PG8_MMA(1, 1, At, B1); PG8_BAR; PG8_SCHED;
        }
        if (wr == 0) PG8_BAR;
        E(acc, cur, wr, wc, fr, fq);
        if (!has_next) break;
#pragma unroll
        for (int a = 0; a < 2; ++a)
#pragma unroll
            for (int b = 0; b < 2; ++b)
#pragma unroll
                for (int m = 0; m < 4; ++m)
#pragma unroll
                    for (int n = 0; n < 2; ++n) acc[a][b][m][n] = (f32x4){0.f, 0.f, 0.f, 0.f};
        cur = nxt; cA = nA; cB = nB; ++ui;
        if (wr == 1) PG8_BAR;
    }
    PG8_WAIT_V(0);
    PG8_BAR;
#undef PG8_SA
#undef PG8_SB
#undef PG8_STAGE
#undef PG8_LDA
#undef PG8_LDB
#undef PG8_MMA
#undef PG8_WAIT_V
#undef PG8_WAIT_L
#undef PG8_BAR
#undef PG8_SCHED
}
}

#define XB_TMO      128
#define XB_XCNT(j)  (256  + 64 * (j))
#define XB_XSUB(j)  (1280 + 64 * (j))
#define XB_XGEN(j)  (2304 + 64 * (j))
#define XB_TOP      3328
#define XB_TOPGEN   3392
#define XCD_BAR_WORDS 3456
#define XB_SPIN_CAP (1u << 22)
__device__ __forceinline__ unsigned xb_ld(unsigned* p)              { return __hip_atomic_load(p, __ATOMIC_RELAXED, __HIP_MEMORY_SCOPE_AGENT); }
__device__ __forceinline__ unsigned xb_add(unsigned* p, unsigned v) { return __hip_atomic_fetch_add(p, v, __ATOMIC_RELAXED, __HIP_MEMORY_SCOPE_AGENT); }
__device__ __forceinline__ unsigned xb_xcc_id() { return (unsigned)__builtin_amdgcn_s_getreg((3 << 11) | 20) & 0xFu; }
#define XB_SPIN(cond, bar) do { unsigned _sp = 0; while (cond) { __builtin_amdgcn_s_sleep(1); \
    if ((++_sp & 255u) == 0u) { if (xb_ld(&(bar)[XB_TMO])) break; if (_sp > XB_SPIN_CAP) { atomicAdd(&(bar)[XB_TMO], 1u); break; } } } } while (0)
__device__ __forceinline__ void xcd_barrier_post(unsigned* bar) {
    if (threadIdx.x == 0) (void)xb_add(&bar[XB_XCNT(xb_xcc_id())], 1u);
}
__device__ __forceinline__ void xcd_barrier_complete(unsigned* bar, unsigned x, unsigned& nloc, unsigned& nx) {
    const unsigned G = gridDim.x * gridDim.y * gridDim.z;
    unsigned sum, cnt, sp = 0u;
    for (;;) {
        sum = 0u; cnt = 0u;
#pragma unroll 1
        for (unsigned j = 0; j < 16; ++j) { const unsigned c = xb_ld(&bar[XB_XCNT(j)]); sum += c; cnt += (c > 0u) ? 1u : 0u; }
        if (sum == G) break;
        __builtin_amdgcn_s_sleep(1);
        if ((++sp & 255u) == 0u) { if (xb_ld(&bar[XB_TMO])) break; if (sp > XB_SPIN_CAP) { atomicAdd(&bar[XB_TMO], 1u); break; } }
    }
    const unsigned mine = xb_ld(&bar[XB_XCNT(x)]);
    nloc = mine > 0u ? mine : 1u; nx = cnt > 0u ? cnt : 1u;
}
__device__ __forceinline__ void xcd_barrier_impl(unsigned* bar_in, volatile LAS unsigned* st) {
    asm volatile("s_waitcnt vmcnt(0)" ::: "memory");
    __syncthreads();
    if (threadIdx.x == 0) {
        unsigned* bar = bar_in; asm volatile("" : "+v"(bar));
        const unsigned x = xb_xcc_id();
        __builtin_amdgcn_s_waitcnt(0);
        unsigned nloc = st[0], nx = st[1];
        if (nloc == 0u) { xcd_barrier_complete(bar, x, nloc, nx); st[0] = nloc; st[1] = nx; }
        const unsigned old = xb_add(&bar[XB_XSUB(x)], 1u);
        const unsigned gen = old / nloc;
        if (old + 1u == (gen + 1u) * nloc) {
            __builtin_amdgcn_fence(__ATOMIC_RELEASE, "agent");
            asm volatile("s_waitcnt vmcnt(0)" ::: "memory");
            const unsigned og = xb_add(&bar[XB_TOP], 1u);
            const unsigned tg = og / nx;
            if (og + 1u == (tg + 1u) * nx) xb_add(&bar[XB_TOPGEN], 1u);
            else XB_SPIN(xb_ld(&bar[XB_TOPGEN]) == tg, bar);
            __builtin_amdgcn_fence(__ATOMIC_ACQUIRE, "agent");
            xb_add(&bar[XB_XGEN(x)], 1u);
            asm volatile("s_waitcnt vmcnt(0)" ::: "memory");
        } else {
            XB_SPIN(xb_ld(&bar[XB_XGEN(x)]) == gen, bar);
            __builtin_amdgcn_fence(__ATOMIC_ACQUIRE, "agent");
            asm volatile("s_waitcnt vmcnt(0)" ::: "memory");
        }
    }
    __syncthreads();
}

template <int CTRL> __device__ __forceinline__ float dpp(float x) { return __builtin_bit_cast(float, __builtin_amdgcn_mov_dpp(__builtin_bit_cast(int, x), CTRL, 0xf, 0xf, true)); }
__device__ __forceinline__ float xlane(float v, int src_lane) { return __builtin_bit_cast(float, __builtin_amdgcn_ds_bpermute(src_lane << 2, __builtin_bit_cast(int, v))); }
__device__ __forceinline__ float wave_sum(float v, int lane) {
    v += dpp<0xB1>(v); v += dpp<0x4E>(v); v += dpp<0x141>(v); v += dpp<0x140>(v);
    v += xlane(v, lane ^ 16); v += xlane(v, lane ^ 32);
    return v;
}
__device__ __forceinline__ float sigmoidf_(float x) { return __builtin_amdgcn_rcpf(1.0f + __expf(-x)); }
__device__ __forceinline__ float siluf_(float x) { return x * __builtin_amdgcn_rcpf(1.0f + __expf(-x)); }
__device__ __forceinline__ float gelu_tanh(float x) { const float u = 1.5957691216f * (x + 0.044715f * x * x * x); return x * __builtin_amdgcn_rcpf(1.0f + __expf(-u)); }

struct Args { const float* in[36]; float* out; unsigned char* ws; };
struct Frame { LAS unsigned char* lds; int tid, lane, wave, bx, G, vcu; };
__device__ __forceinline__ Frame mkframe(int wv) {
    Frame F; unsigned z; asm volatile("s_mov_b32 %0, 0" : "=s"(z)); F.lds = (LAS unsigned char*)(uintptr_t)z;
    int l_; asm volatile("v_mbcnt_lo_u32_b32 %0, -1, 0\n\tv_mbcnt_hi_u32_b32 %0, -1, %0" : "=v"(l_)); asm volatile("" : "+s"(wv)); F.lane = l_; F.wave = wv; F.tid = wv * 64 + l_;
    int bx = blockIdx.x; asm volatile("" : "+s"(bx)); F.bx = bx; int G = gridDim.x; asm volatile("" : "+s"(G)); F.G = G;
    F.vcu = (G % 8 == 0) ? (bx % 8) * (G / 8) + bx / 8 : bx;
    return F;
}
constexpr int PTAB_OFF = LDSCTL_OFF + 1024;
__device__ __forceinline__ unsigned long long ptab_rd(const Frame& F, int i) {
    const unsigned long long v = ((volatile LAS unsigned long long*)(F.lds + PTAB_OFF))[i];
    const unsigned lo = __builtin_amdgcn_readfirstlane((unsigned)v), hi = __builtin_amdgcn_readfirstlane((unsigned)(v >> 32));
    return ((unsigned long long)hi << 32) | lo;
}
__device__ __forceinline__ const float* inptr(const Frame& F, int i) { return (const float*)ptab_rd(F, i); }
__device__ __forceinline__ float* outptr(const Frame& F) { return (float*)ptab_rd(F, 36); }
__device__ __forceinline__ unsigned char* wsptr(const Frame& F) { return (unsigned char*)ptab_rd(F, 37); }

__device__ __forceinline__ void transpose_item64(const float* W, int ld, int srccol, bf16* WT, int K, int d0, int k0, LAS unsigned* scr, int lane) {
    const int g = lane >> 4, fr = lane & 15;
    f32x4 v[16];
#pragma unroll
    for (int p = 0; p < 8; ++p)
#pragma unroll
        for (int e = 0; e < 2; ++e) { const int k = 8 * p + 2 * g + e; v[2 * p + e] = srccol >= 0 ? __builtin_nontemporal_load((const GAS f32x4*)(W + (size_t)(k0 + k) * ld + srccol)) : (f32x4){0.f, 0.f, 0.f, 0.f}; }
#pragma unroll
    for (int p = 0; p < 8; ++p) { const int kp = 4 * p + g;
#pragma unroll
        for (int i = 0; i < 4; ++i) scr[kp * 65 + 4 * fr + i] = pk2(v[2 * p][i], v[2 * p + 1][i]); }
    LDS_WAIT(); asm volatile("" ::: "memory");
    const int c = lane & 7;
#pragma unroll
    for (int j = 0; j < 8; ++j) { const int n = (lane >> 3) + 8 * j;
        u32x4 o; o.x = scr[(4 * c + 0) * 65 + n]; o.y = scr[(4 * c + 1) * 65 + n]; o.z = scr[(4 * c + 2) * 65 + n]; o.w = scr[(4 * c + 3) * 65 + n];
        *(GAS u32x4*)(WT + (size_t)(d0 + n) * K + k0 + 8 * c) = o; }
    LDS_WAIT(); asm volatile("" ::: "memory");
}
__device__ __forceinline__ int win_map(int d) {
    if (d < 96) return 6144 + d;
    if (d < 192) return 6240 + (d - 96);
    if (d < 448) return 6336 + (d - 192);
    if (d < 496) return 17600 + (d - 448);
    if (d < 512) return -1;
    if (d < 4608) return 6592 + (d - 512);
    if (d < 7680) return 10688 + (d - 4608);
    if (d < 9984) { const int e = d - 7680, ty = e / 768; return 13760 + ty * 1280 + (e - ty * 768); }
    if (d < 10496) return 14528 + (d - 9984);
    if (d < 11008) return 15808 + (d - 10496);
    if (d < 11520) return 17088 + (d - 11008);
    if (d < 17664) return d - 11520;
    return 17648 + (d - 17664);
}

__device__ __forceinline__ void phase_convert(int wv, int l) {
    const Frame F = mkframe(wv); unsigned char* ws = wsptr(F);
    const int tid = F.tid, lane = F.lane, wave = F.wave;
    LAS unsigned* scr = (LAS unsigned*)(F.lds + wave * 8448);
    const int gw = F.vcu * NWAVES + wave, NGW = F.G * NWAVES;
    constexpr int I_UP = (2 * FF / 64) * (D / 64), I_DN = (D / 64) * (FF / 64), I_IN = (23808 / 64) * (D / 64), I_DD = (D / 64) * (D / 64);
    constexpr int NIT = 2 * I_UP + 2 * I_DN + I_IN + 4 * I_DD;
    const int n4 = 4 * (lane & 15);
    for (int it = gw; it < NIT; it += NGW) {
        int r = it;
        if (r < 2 * I_UP) { const int which = r / I_UP; r -= which * I_UP; const int nb = r / (D / 64), kb = r % (D / 64), d0 = nb * 64;
            const int pn = d0 >> 8, half = (d0 >> 7) & 1, i0 = d0 & 127;
            const float* src = inptr(F, (which ? 31 : 28) + half) + (size_t)l * D * FF;
            transpose_item64(src, FF, 128 * pn + i0 + n4, (bf16*)(ws + (which ? WS_W2U : WS_W1U)), D, d0, kb * 64, scr, lane); continue; }
        r -= 2 * I_UP;
        if (r < 2 * I_DN) { const int which = r / I_DN; r -= which * I_DN; const int nb = r / (FF / 64), kb = r % (FF / 64), d0 = nb * 64;
            const float* src = inptr(F, which ? 33 : 30) + (size_t)l * FF * D;
            transpose_item64(src, D, d0 + n4, (bf16*)(ws + (which ? WS_W2D : WS_W1D)), FF, d0, kb * 64, scr, lane); continue; }
        r -= 2 * I_DN;
        if (r < I_IN) { const int nb = r / (D / 64), kb = r % (D / 64), d0 = nb * 64;
            const float* src = inptr(F, 1) + (size_t)l * D * C_IN;
            transpose_item64(src, C_IN, win_map(d0 + n4), (bf16*)(ws + WS_WIN), D, d0, kb * 64, scr, lane); continue; }
        r -= I_IN;
        { const int which = r / I_DD; r -= which * I_DD; const int nb = r / (D / 64), kb = r % (D / 64), d0 = nb * 64;
            const float* src = which < 3 ? inptr(F, 26) + ((size_t)l * 3 + which) * D * D : inptr(F, 27) + (size_t)l * D * D;
            transpose_item64(src, D, d0 + n4, (bf16*)(ws + (which < 3 ? WS_WBR + which * SZ_DD : WS_WO)), D, d0, kb * 64, scr, lane); }
    }
    if (l == 0) {
        const float* x = inptr(F, 0); bf16* XB = (bf16*)(ws + WS_XB);
        const size_t n4 = (size_t)M * D / 4, stride = (size_t)F.G * NTHR;
        for (size_t i = (size_t)F.bx * NTHR + tid; i < n4; i += 4 * stride) {
            f32x4 v[4];
#pragma unroll
            for (int q = 0; q < 4; ++q) v[q] = ((const GAS f32x4*)x)[i + q * stride < n4 ? i + q * stride : i];
#pragma unroll
            for (int q = 0; q < 4; ++q) if (i + q * stride < n4) { u32x2 o; o.x = pk2(v[q].x, v[q].y); o.y = pk2(v[q].z, v[q].w); ((GAS u32x2*)XB)[i + q * stride] = o; } }
    }
}

__device__ __forceinline__ void phase_ln(int wv, int l, int which) {
    const Frame F = mkframe(wv); const int lane = F.lane, wave = F.wave;
    float* X = outptr(F); bf16* XB = (bf16*)(wsptr(F) + WS_XB); const float* g = inptr(F, 34) + ((size_t)l * 3 + which) * D; const float* b = inptr(F, 35) + ((size_t)l * 3 + which) * D;
    float* stats = (float*)(wsptr(F) + WS_LNS); const bool final = (l == DEPTH - 1 && which == 2);
    const int gw = F.vcu * NWAVES + wave, NGW = F.G * NWAVES;
    f32x4 nx[8];
    { const GAS f32x4* xr = (const GAS f32x4*)(X + (size_t)min(gw, M - 1) * D) + lane;
#pragma unroll
      for (int j = 0; j < 8; ++j) nx[j] = xr[64 * j]; }
    for (int row = gw; row < M; row += NGW) {
        GAS f32x4* xr = (GAS f32x4*)(X + (size_t)row * D) + lane;
        f32x4 v[8]; float s = 0.f;
#pragma unroll
        for (int j = 0; j < 8; ++j) { v[j] = nx[j]; s += (v[j].x + v[j].y) + (v[j].z + v[j].w); }
        { const GAS f32x4* xn = (const GAS f32x4*)(X + (size_t)min(row + NGW, M - 1) * D) + lane;
#pragma unroll
          for (int j = 0; j < 8; ++j) nx[j] = xn[64 * j]; }
        const float mean = wave_sum(s, lane) * (1.f / D); float s2 = 0.f;
#pragma unroll
        for (int j = 0; j < 8; ++j) { v[j] = v[j] - mean; s2 += (v[j].x * v[j].x + v[j].y * v[j].y) + (v[j].z * v[j].z + v[j].w * v[j].w); }
        const float rstd = 1.f / sqrtf(wave_sum(s2, lane) * (1.f / D) + LN_EPS);
        GAS u32x2* o8 = (GAS u32x2*)(XB + (size_t)row * D) + lane;
#pragma unroll
        for (int j = 0; j < 8; ++j) { const f32x4 gg = ((const GAS f32x4*)g)[lane + 64 * j], bb = ((const GAS f32x4*)b)[lane + 64 * j];
            const f32x4 y = v[j] * rstd * gg + bb; if (final) xr[64 * j] = y; else { u32x2 o; o.x = pk2(y.x, y.y); o.y = pk2(y.z, y.w); o8[64 * j] = o; } }
        if (lane == 0) *(GAS f32x2*)(stats + 2 * row) = (f32x2){mean, rstd};
    }
}

__device__ __forceinline__ int fresh_lane() { int l; asm volatile("v_mbcnt_lo_u32_b32 %0, -1, 0\n\tv_mbcnt_hi_u32_b32 %0, -1, %0" : "=v"(l)); return l; }

using pg8::Unit;
struct EpiSwiGLU {
    bf16* H;
    __device__ __forceinline__ void operator()(const f32x4 (&acc)[2][2][4][2], const Unit& u, int wr, int wc, int fr_, int fq_) const { const int l__ = fresh_lane(), fr = l__ & 15, fq = l__ >> 4; (void)fr_; (void)fq_;
        const int col = u.pn * 128 + wc * 32 + 8 * fq;
#pragma unroll
        for (int ai = 0; ai < 2; ++ai)
#pragma unroll
            for (int m = 0; m < 4; ++m) { const int row = u.pm * 256 + ai * 128 + wr * 64 + m * 16 + fr;
                const f32x4 g0 = acc[ai][0][m][0], g1 = acc[ai][0][m][1], u0 = acc[ai][1][m][0], u1 = acc[ai][1][m][1];
                u32x4 w; w.x = pk2h(siluf_(g0[0]) * u0[0], siluf_(g0[1]) * u0[1]); w.y = pk2h(siluf_(g0[2]) * u0[2], siluf_(g0[3]) * u0[3]);
                w.z = pk2h(siluf_(g1[0]) * u1[0], siluf_(g1[1]) * u1[1]); w.w = pk2h(siluf_(g1[2]) * u1[2], siluf_(g1[3]) * u1[3]);
                *(GAS u32x4*)(H + (size_t)row * FF + col) = w; }
    }
};
template <bool LN> struct EpiResid {
    float* X; const float* Xr; float s; const float* stats; const float* lng; const float* lnb;
    __device__ __forceinline__ void operator()(const f32x4 (&acc)[2][2][4][2], const Unit& u, int wr, int wc, int fr_, int fq_) const { const int l__ = fresh_lane(), fr = l__ & 15, fq = l__ >> 4; (void)fr_; (void)fq_;
#pragma unroll
        for (int bj = 0; bj < 2; ++bj) { const int col = u.pn * 256 + bj * 128 + wc * 32 + 8 * fq;
            f32x4 g0 = (f32x4){1.f, 1.f, 1.f, 1.f}, g1 = g0, b0 = (f32x4){0.f, 0.f, 0.f, 0.f}, b1 = b0;
            if (LN) { g0 = *(const GAS f32x4*)(lng + col); g1 = *(const GAS f32x4*)(lng + col + 4); b0 = *(const GAS f32x4*)(lnb + col); b1 = *(const GAS f32x4*)(lnb + col + 4); }
#pragma unroll
            for (int ai = 0; ai < 2; ++ai) {
                f32x4 xv[4][2]; f32x2 st[4];
#pragma unroll
                for (int m = 0; m < 4; ++m) { const int row = u.pm * 256 + ai * 128 + wr * 64 + m * 16 + fr;
                    const GAS f32x4* p = (const GAS f32x4*)(Xr + (size_t)row * D + col); xv[m][0] = p[0]; xv[m][1] = p[1];
                    if (LN) st[m] = *(const GAS f32x2*)(stats + 2 * row); }
#pragma unroll
                for (int m = 0; m < 4; ++m) { const int row = u.pm * 256 + ai * 128 + wr * 64 + m * 16 + fr;
                    GAS f32x4* p = (GAS f32x4*)(X + (size_t)row * D + col);
                    f32x4 x0 = xv[m][0], x1 = xv[m][1];
                    if (LN) { x0 = (x0 - st[m].x) * st[m].y * g0 + b0; x1 = (x1 - st[m].x) * st[m].y * g1 + b1; }
                    p[0] = x0 * ALPHA + acc[ai][bj][m][0] * s; p[1] = x1 * ALPHA + acc[ai][bj][m][1] * s; } } }
    }
};
__device__ __forceinline__ void phase_scale_unused(Frame& F, float* X) {
    const size_t n4 = (size_t)M * D / 4;
    const int tid = opaque_tid();
    for (size_t i = (size_t)blockIdx.x * NTHR + tid; i < n4; i += (size_t)F.G * NTHR) { GAS f32x4* p = (GAS f32x4*)X + i; *p = *p * ALPHA; }
}


__device__ __forceinline__ u32x4 pack8(const f32x4 a, const f32x4 b) { u32x4 w; w.x = pk2(a[0], a[1]); w.y = pk2(a[2], a[3]); w.z = pk2(b[0], b[1]); w.w = pk2(b[2], b[3]); return w; }
__device__ __forceinline__ u32x4 pack8h(const f32x4 a, const f32x4 b) { u32x4 w; w.x = pk2h(a[0], a[1]); w.y = pk2h(a[2], a[3]); w.z = pk2h(b[0], b[1]); w.w = pk2h(b[2], b[3]); return w; }
__device__ __forceinline__ void unpack8(const u32x4 w, f32x4& a, f32x4& b) { a = (f32x4){bflo(w.x), bfhi(w.x), bflo(w.y), bfhi(w.y)}; b = (f32x4){bflo(w.z), bfhi(w.z), bflo(w.w), bfhi(w.w)}; }
#define EPI_ROWS_BEGIN _Pragma("unroll") for (int ai = 0; ai < 2; ++ai) _Pragma("unroll") for (int m = 0; m < 4; ++m) { const int row = u.pm * 256 + ai * 128 + wr * 64 + m * 16 + fr; _Pragma("unroll") for (int bj = 0; bj < 2; ++bj) { \
    const int col = u.pn * 256 + bj * 128 + wc * 32 + 8 * fq; f32x4 v0 = acc[ai][bj][m][0], v1 = acc[ai][bj][m][1];
#define EPI_ROWS_END } }
#define EPI_ARGS const f32x4 (&acc)[2][2][4][2], const Unit& u, int wr, int wc, int fr_, int fq_
#define EPI_LANE const int l__ = fresh_lane(), fr = l__ & 15, fq = l__ >> 4; (void)fr_; (void)fq_;

struct EpiBf16 {
    bf16* O; int ldc, ncol, nrow;
    __device__ __forceinline__ void operator()(EPI_ARGS) const { EPI_LANE
        EPI_ROWS_BEGIN
            if (col < ncol && row < nrow) *(GAS u32x4*)(O + (size_t)row * ldc + col) = pack8h(v0, v1);
        EPI_ROWS_END
    }
};
struct EpiBf16Quarter {
    bf16* O; int ldc, p;
    __device__ __forceinline__ void operator()(EPI_ARGS) const { EPI_LANE
        EPI_ROWS_BEGIN
            if ((col >> 6) == p) *(GAS u32x4*)(O + (size_t)row * ldc + col) = pack8h(v0, v1);
        EPI_ROWS_END
    }
};
struct EpiSigmoid {
    bf16* O; int ldc;
    __device__ __forceinline__ void operator()(EPI_ARGS) const { EPI_LANE
        EPI_ROWS_BEGIN
#pragma unroll
            for (int j = 0; j < 4; ++j) { v0[j] = sigmoidf_(v0[j]); v1[j] = sigmoidf_(v1[j]); }
            *(GAS u32x4*)(O + (size_t)row * ldc + col) = pack8h(v0, v1);
        EPI_ROWS_END
    }
};
struct EpiCmp1 {
    bf16* O; const float* bias;
    __device__ __forceinline__ void operator()(EPI_ARGS) const { EPI_LANE
        EPI_ROWS_BEGIN
            const f32x4 b0 = *(const GAS f32x4*)(bias + col), b1 = *(const GAS f32x4*)(bias + col + 4);
#pragma unroll
            for (int j = 0; j < 4; ++j) { v0[j] = gelu_tanh(v0[j] + b0[j]); v1[j] = gelu_tanh(v1[j] + b1[j]); }
            *(GAS u32x4*)(O + (size_t)row * 256 + col) = ((row & 255) == 255) ? (u32x4){0u, 0u, 0u, 0u} : pack8h(v0, v1);
        EPI_ROWS_END
    }
};
constexpr float QSCALE = 0.07216878364870322f * 1.4426950408889634f;
struct EpiInA {
    float* LG; bf16* GU; bf16* QB; bf16* K3; bf16* VC;
    __device__ __forceinline__ void operator()(EPI_ARGS) const { EPI_LANE
        const int pn = u.pn;
        if (pn < 2) {
            EPI_ROWS_BEGIN
                GAS f32x4* p = (GAS f32x4*)(LG + (size_t)row * 512 + col); p[0] = v0; p[1] = v1;
            EPI_ROWS_END
        } else if (pn < 18) {
            EPI_ROWS_BEGIN
#pragma unroll
                for (int j = 0; j < 4; ++j) { v0[j] = gelu_tanh(v0[j]); v1[j] = gelu_tanh(v1[j]); }
                *(GAS u32x4*)(GU + (size_t)row * 4096 + (col - 512)) = pack8h(v0, v1);
            EPI_ROWS_END
        } else if (pn < 30) {
            EPI_ROWS_BEGIN
                *(GAS u32x4*)(QB + (size_t)row * 3072 + (col - 4608)) = pack8h(v0 * QSCALE, v1 * QSCALE);
            EPI_ROWS_END
        } else if (pn < 39) {
            EPI_ROWS_BEGIN
                const int e = col - 7680, ty = e / 768, cg = e - ty * 768, gg = cg / 192, dd = cg - gg * 192, bb = row >> 12, tt = row & 4095;
                *(GAS u32x4*)(K3 + ((size_t)((ty * 4 + bb) * 4 + gg) * T + tt) * 192 + dd) = pack8h(v0, v1);
            EPI_ROWS_END
        } else {
            EPI_ROWS_BEGIN
                const int e = col - 9984, gg = e >> 7, dd = e & 127, bb = row >> 12, tt = row & 4095;
                *(GAS u32x4*)(VC + ((size_t)(bb * 4 + gg) * T + tt) * 128 + dd) = pack8h(v0, v1);
            EPI_ROWS_END
        }
    }
};
struct EpiLoraWA {
    float* DEC; bf16* AG; const float* w0; const float* a0;
    __device__ __forceinline__ void operator()(EPI_ARGS) const { EPI_LANE
        if (u.pn < 8) {
            EPI_ROWS_BEGIN
                const f32x4 b0 = *(const GAS f32x4*)(w0 + col), b1 = *(const GAS f32x4*)(w0 + col + 4);
#pragma unroll
                for (int j = 0; j < 4; ++j) {
                    v0[j] = __expf(-0.60653065971263342f * sigmoidf_(v0[j] + b0[j]));
                    v1[j] = __expf(-0.60653065971263342f * sigmoidf_(v1[j] + b1[j])); }
                GAS f32x4* p = (GAS f32x4*)(DEC + (size_t)row * D + col); p[0] = v0; p[1] = v1;
            EPI_ROWS_END
        } else {
            EPI_ROWS_BEGIN
                const int c = col - 2048;
                const f32x4 b0 = *(const GAS f32x4*)(a0 + c), b1 = *(const GAS f32x4*)(a0 + c + 4);
#pragma unroll
                for (int j = 0; j < 4; ++j) { v0[j] = sigmoidf_(v0[j] + b0[j]); v1[j] = sigmoidf_(v1[j] + b1[j]); }
                *(GAS u32x4*)(AG + (size_t)row * D + c) = pack8h(v0, v1);
            EPI_ROWS_END
        }
    }
};
struct EpiVmix {
    bf16* VS; const bf16* VF; const float* v0b;
    __device__ __forceinline__ void operator()(EPI_ARGS) const { EPI_LANE
        EPI_ROWS_BEGIN
            const f32x4 b0 = *(const GAS f32x4*)(v0b + col), b1 = *(const GAS f32x4*)(v0b + col + 4);
            f32x4 s0, s1, f0, f1; unpack8(*(const GAS u32x4*)(VS + (size_t)row * D + col), s0, s1); unpack8(*(const GAS u32x4*)(VF + (size_t)row * D + col), f0, f1);
#pragma unroll
            for (int j = 0; j < 4; ++j) { v0[j] = s0[j] + (f0[j] - s0[j]) * sigmoidf_(v0[j] + b0[j]); v1[j] = s1[j] + (f1[j] - s1[j]) * sigmoidf_(v1[j] + b1[j]); }
            *(GAS u32x4*)(VS + (size_t)row * D + col) = pack8h(v0, v1);
        EPI_ROWS_END
    }
};
template <int MODE> struct EpiMerge {
    float* M32; bf16* MB; const bf16* G;
    __device__ __forceinline__ void operator()(EPI_ARGS) const { EPI_LANE
        EPI_ROWS_BEGIN
            f32x4 g0, g1; unpack8(*(const GAS u32x4*)(G + (size_t)row * 6144 + col), g0, g1);
            v0 = v0 * g0; v1 = v1 * g1;
            GAS u32x4* p = (GAS u32x4*)(MB + (size_t)row * D + col);
            if (MODE >= 1) { f32x4 p0, p1; unpack8(*p, p0, p1); v0 += p0; v1 += p1; }
            *p = pack8h(v0, v1);
        EPI_ROWS_END
    }
};

template <class F_> __device__ __forceinline__ void small_convert(const Frame& F, int tid, bf16* dst, int rows, int dk, F_ val) {
    const int total = rows * (dk / 8);
    for (int e = F.bx * NTHR + tid; e < total; e += F.G * NTHR) { const int kc = e / rows, n = e - kc * rows, k0 = kc * 8;
        u32x4 o; o.x = pk2(val(n, k0), val(n, k0 + 1)); o.y = pk2(val(n, k0 + 2), val(n, k0 + 3)); o.z = pk2(val(n, k0 + 4), val(n, k0 + 5)); o.w = pk2(val(n, k0 + 6), val(n, k0 + 7));
        *(GAS u32x4*)(dst + (size_t)n * dk + k0) = o; }
}
__device__ __forceinline__ void phase_convert_small(int wv, int l) {
    const Frame F = mkframe(wv); unsigned char* ws = wsptr(F); const int tid = F.tid;
    { const float* w2 = inptr(F, 4) + (size_t)l * 96 * D; const float* a2 = inptr(F, 6) + (size_t)l * 96 * D;
      small_convert(F, tid, (bf16*)(ws + WS_LWA), 4096, 256, [=](int n, int k) { return n < 2048 ? (k < 96 ? w2[(size_t)k * D + n] : 0.f) : ((k >= 96 && k < 192) ? a2[(size_t)(k - 96) * D + (n - 2048)] : 0.f); }); }
    { const float* g2 = inptr(F, 7) + (size_t)l * 256 * D;
      small_convert(F, tid, (bf16*)(ws + WS_LG2), 2048, 256, [=](int n, int k) { return g2[(size_t)k * D + n]; }); }
    if (l > 0) {
      const float* v1 = inptr(F, 9) + (size_t)(l - 1) * D * 64; const float* v2 = inptr(F, 10) + (size_t)(l - 1) * 64 * D;
      small_convert(F, tid, (bf16*)(ws + WS_LV1), 256, 2048, [=](int n, int k) { return (k >> 9) == (n >> 6) ? v1[(size_t)k * 64 + (n & 63)] : 0.f; });
      small_convert(F, tid, (bf16*)(ws + WS_LV2), 2048, 256, [=](int n, int k) { return v2[(size_t)(k & 63) * D + n]; }); }
    { const float* k1 = inptr(F, 22) + (size_t)l * 6144 * 192; const float* k2 = inptr(F, 23) + (size_t)l * 192 * 192;
      const float* v1 = inptr(F, 24) + (size_t)l * 4096 * 128; const float* v2 = inptr(F, 25) + (size_t)l * 128 * 128;
      small_convert(F, tid, (bf16*)(ws + WS_PK1), 256, 6144, [=](int n, int k) { return n < 192 ? k1[(size_t)k * 192 + n] : 0.f; });
      small_convert(F, tid, (bf16*)(ws + WS_PK2), 256, 256, [=](int n, int k) { return (n < 192 && k < 192) ? k2[(size_t)k * 192 + n] : 0.f; });
      small_convert(F, tid, (bf16*)(ws + WS_PV1), 256, 4096, [=](int n, int k) { return n < 128 ? v1[(size_t)k * 128 + n] : 0.f; });
      small_convert(F, tid, (bf16*)(ws + WS_PV2), 256, 256, [=](int n, int k) { return (n < 128 && k < 128) ? v2[(size_t)k * 128 + n] : 0.f; });
      float* b1 = (float*)(ws + WS_B1) + l * 512;
      const float* pk = inptr(F, 20) + (size_t)l * 6144; const float* pv = inptr(F, 21) + (size_t)l * 4096;
      for (int o = F.bx * NWAVES + F.wave; o < 320; o += F.G * NWAVES) {
          float sacc = 0.f;
          if (o < 192) { for (int j = F.lane; j < 6144; j += 64) sacc += pk[j] * k1[(size_t)j * 192 + o]; }
          else { for (int j = F.lane; j < 4096; j += 64) sacc += pv[j] * v1[(size_t)j * 128 + (o - 192)]; }
          sacc = wave_sum(sacc, F.lane);
          if (F.lane == 0) b1[o < 192 ? o : 256 + (o - 192)] = sacc;
      }
    }
}

__device__ __forceinline__ void phase_gm_stats(int wv) {
    const Frame F = mkframe(wv); unsigned char* ws = wsptr(F); const int lane = F.lane, wave = F.wave;
    const bf16* GU = (const bf16*)(ws + WS_GU); float* GST = (float*)(ws + WS_GST);
    const int NGW = F.G * NWAVES;
    for (int row0 = F.vcu * NWAVES + wave; row0 < M; row0 += 4 * NGW) {
        u32x4 raw[4][4];
#pragma unroll
        for (int r = 0; r < 4; ++r) { const int row = min(row0 + r * NGW, M - 1); const GAS u32x4* p = (const GAS u32x4*)(GU + (size_t)row * 4096 + 2048) + lane;
#pragma unroll
            for (int j = 0; j < 4; ++j) raw[r][j] = p[64 * j]; }
#pragma unroll
        for (int r = 0; r < 4; ++r) { const int row = row0 + r * NGW;
            f32x4 v[8]; float s = 0.f;
#pragma unroll
            for (int j = 0; j < 4; ++j) unpack8(raw[r][j], v[2 * j], v[2 * j + 1]);
#pragma unroll
            for (int j = 0; j < 8; ++j) s += (v[j][0] + v[j][1]) + (v[j][2] + v[j][3]);
            const float mean = wave_sum(s, lane) * (1.f / 2048.f); float s2 = 0.f;
#pragma unroll
            for (int j = 0; j < 8; ++j) { const f32x4 d = v[j] - mean; s2 += (d[0] * d[0] + d[1] * d[1]) + (d[2] * d[2] + d[3] * d[3]); }
            const float rstd = 1.f / sqrtf(wave_sum(s2, lane) * (1.f / 2048.f) + LN_EPS);
            if (lane == 0 && row < M) { GST[2 * row] = mean; GST[2 * row + 1] = rstd; } }
    }
}

__device__ __forceinline__ void phase_gmlp(int wv, int l) {
    const Frame F = mkframe(wv); unsigned char* ws = wsptr(F); const int tid = F.tid, lane = F.lane, wave = F.wave, fr = lane & 15, fq = lane >> 4;
    const bf16* GU = (const bf16*)(ws + WS_GU); const float* GST = (const float*)(ws + WS_GST); bf16* YGM = (bf16*)(ws + WS_YGM);
    const float* lng = inptr(F, 16) + (size_t)l * D; const float* lnb = inptr(F, 17) + (size_t)l * D;
    const float* gws = inptr(F, 18) + (size_t)l * 16 * 128 * 128; const float* gbs = inptr(F, 19) + (size_t)l * 16 * 128;
    LAS unsigned char* VTl = F.lds; LAS unsigned char* Wl = F.lds + 34816;
    const int s_ = tid >> 2, cq = tid & 3;
    int g_staged = -1;
    u32x4 vraw[4]; float mean, rstd;
    { const int uid = min(F.vcu, 2047); const int g = uid & 15, c = (uid >> 4) & 31, b = uid >> 9; const int token = b * T + c * 128 + s_;
      mean = GST[2 * token]; rstd = GST[2 * token + 1];
#pragma unroll
      for (int i = 0; i < 4; ++i) vraw[i] = *(const GAS u32x4*)(GU + (size_t)token * 4096 + 2048 + g * 128 + cq * 8 + 32 * i); }
    for (int uid = F.vcu; uid < 2048; uid += F.G) {
        const int g = uid & 15, c = (uid >> 4) & 31, b = uid >> 9;
        const int tok0 = b * T + c * 128;
        {
#pragma unroll
            for (int i = 0; i < 4; ++i) { const int ch = cq * 8 + 32 * i; f32x4 a, bq; unpack8(vraw[i], a, bq);
                const f32x4 g0 = *(const GAS f32x4*)(lng + g * 128 + ch), g1 = *(const GAS f32x4*)(lng + g * 128 + ch + 4), b0 = *(const GAS f32x4*)(lnb + g * 128 + ch), b1 = *(const GAS f32x4*)(lnb + g * 128 + ch + 4);
                a = (a - mean) * rstd * g0 + b0; bq = (bq - mean) * rstd * g1 + b1;
#pragma unroll
                for (int j = 0; j < 4; ++j) { *(LAS unsigned short*)(VTl + (ch + j) * 272 + s_ * 2) = (unsigned short)f2bf(a[j]); *(LAS unsigned short*)(VTl + (ch + 4 + j) * 272 + s_ * 2) = (unsigned short)f2bf(bq[j]); } }
            if (g != g_staged) {
                g_staged = g;
                const float* wrow = gws + ((size_t)g * 128 + s_) * 128 + cq * 32;
#pragma unroll
                for (int i = 0; i < 4; ++i) { f32x4 a = *(const GAS f32x4*)(wrow + 8 * i), bq = *(const GAS f32x4*)(wrow + 8 * i + 4);
#pragma unroll
                    for (int j = 0; j < 4; ++j) { if (cq * 32 + 8 * i + j > s_) a[j] = 0.f; if (cq * 32 + 8 * i + 4 + j > s_) bq[j] = 0.f; }
                    *(LAS u32x4*)(Wl + s_ * 272 + (cq * 32 + 8 * i) * 2) = pack8(a, bq); } }
        }
        __syncthreads();
        const int tl = 16 * wave + fr, token = tok0 + tl;
        u32x2 uu[8]; const float bias = gbs[g * 128 + tl];
#pragma unroll
        for (int dt = 0; dt < 8; ++dt) uu[dt] = *(const GAS u32x2*)(GU + (size_t)token * 4096 + g * 128 + 16 * dt + 4 * fq);
        { const int un = min(uid + F.G, 2047); const int gn = un & 15, cn = (un >> 4) & 31, bn = un >> 9; const int tokn = bn * T + cn * 128 + s_;
          mean = GST[2 * tokn]; rstd = GST[2 * tokn + 1];
#pragma unroll
          for (int i = 0; i < 4; ++i) vraw[i] = *(const GAS u32x4*)(GU + (size_t)tokn * 4096 + 2048 + gn * 128 + cq * 8 + 32 * i); }
        f32x4 acc[8];
#pragma unroll
        for (int dt = 0; dt < 8; ++dt) acc[dt] = (f32x4){0.f, 0.f, 0.f, 0.f};
#pragma unroll
        for (int ks = 0; ks < 4; ++ks) { const bf16x8 wf = *(const LAS bf16x8*)(Wl + (16 * wave + fr) * 272 + (32 * ks + 8 * fq) * 2);
#pragma unroll
            for (int dt = 0; dt < 8; ++dt) { const bf16x8 vf = *(const LAS bf16x8*)(VTl + (16 * dt + fr) * 272 + (32 * ks + 8 * fq) * 2);
                acc[dt] = __builtin_amdgcn_mfma_f32_16x16x32_bf16(vf, wf, acc[dt], 0, 0, 0); } }
#pragma unroll
        for (int dt = 0; dt < 8; ++dt) { const int d0 = 16 * dt + 4 * fq;
            u32x2 o; o.x = pk2(bflo(uu[dt].x) * (acc[dt][0] + bias), bfhi(uu[dt].x) * (acc[dt][1] + bias)); o.y = pk2(bflo(uu[dt].y) * (acc[dt][2] + bias), bfhi(uu[dt].y) * (acc[dt][3] + bias));
            *(GAS u32x2*)(YGM + (size_t)token * D + g * 128 + d0) = o; }
        asm volatile("s_waitcnt lgkmcnt(0)" ::: "memory"); __builtin_amdgcn_s_barrier(); asm volatile("" ::: "memory");
    }
}
__device__ __forceinline__ void phase_zero(int wv, size_t off) {
    const Frame F = mkframe(wv); bf16* p = (bf16*)(wsptr(F) + off); const int tid = F.tid; const size_t n = (size_t)M * D / 8;
    for (size_t i = (size_t)F.bx * NTHR + tid; i < n; i += (size_t)F.G * NTHR) ((GAS u32x4*)p)[i] = (u32x4){0u, 0u, 0u, 0u};
}


constexpr int AT_KB = 0, AT_KSZ = 24576, AT_VB = 2 * AT_KSZ, AT_VSZ = 16384, AT_IMPA = AT_VB + 2 * AT_VSZ, AT_IMPB = AT_IMPA + 16384, AT_MASK = AT_IMPB + 16384, AT_END = AT_MASK + 512;
static_assert(AT_END <= RING_BYTES, "attention LDS");
struct AttnStage { unsigned koff[3], voff[2]; };
__device__ __forceinline__ void at_offsets(AttnStage& t, int wave, int lane, int vpitch) {
#pragma unroll
    for (int q = 0; q < 3; ++q) { const int P = (3 * wave + q) * 64 + lane, r = P / 24, cs = P - r * 24, c = cs ^ ((r >> 1) & 7); t.koff[q] = (unsigned)(r * 24 + c) * 16u; }
#pragma unroll
    for (int q = 0; q < 2; ++q) { const int P = (2 * wave + q) * 64 + lane, r = P >> 3, cs = P & 7, c = cs ^ ((r >> 1) & 7); t.voff[q] = (unsigned)(r * vpitch) * 2u + (unsigned)c * 16u; }
}
__device__ __forceinline__ void at_issue(const AttnStage& t, int wave, const bf16* kt, const bf16* vt, LAS unsigned char* kb, LAS unsigned char* vb) {
#pragma unroll
    for (int q = 0; q < 3; ++q) __builtin_amdgcn_global_load_lds((const unsigned*)((const char*)kt + t.koff[q]), (LAS unsigned*)(kb + (3 * wave + q) * 1024), 16, 0, 0);
#pragma unroll
    for (int q = 0; q < 2; ++q) __builtin_amdgcn_global_load_lds((const unsigned*)((const char*)vt + t.voff[q]), (LAS unsigned*)(vb + (2 * wave + q) * 1024), 16, 0, 0);
}
template <int MODE, int AMASK = 3>
__device__ __forceinline__ void attn_step(const LAS unsigned char* Kl, const LAS unsigned char* Vl, const bf16x8 (&qf)[2][6], float (&m)[2], float (&l)[2], f32x4 (&O)[8][2],
                                          const int (&lo)[2], const int (&hi)[2], int lane, int fr, int fq, LAS float* impA, LAS float* impB, int sbase) {
    f32x4 st[2][4];
#pragma unroll
    for (int a = 0; a < 2; ++a)
#pragma unroll
        for (int nt = 0; nt < 4; ++nt) st[a][nt] = (f32x4){0.f, 0.f, 0.f, 0.f};
    const int sw = (fr >> 1) & 7, swb = sw >> 2;
    const LAS unsigned char* kbase0 = Kl + fr * 384 + ((fq ^ (sw & 3)) << 4);
    const LAS unsigned char* kb_e = kbase0 + 64 * swb; const LAS unsigned char* kb_o = kbase0 + 64 * (1 - swb);
#define AT_LDK(e) (*(const LAS bf16x8*)(((((e) >> 2) & 1) ? kb_o : kb_e) + 128 * ((e) >> 3) + 6144 * ((e) & 3)))
    { bf16x8 kfr[3]; kfr[0] = AT_LDK(0); kfr[1] = AT_LDK(1);
#pragma unroll
      for (int e = 0; e < 24; ++e) { const int ks = e >> 2, nt = e & 3;
          if (e + 2 < 24) kfr[(e + 2) % 3] = AT_LDK(e + 2);
          if (AMASK & 1) st[0][nt] = __builtin_amdgcn_mfma_f32_16x16x32_bf16(kfr[e % 3], qf[0][ks], st[0][nt], 0, 0, 0);
          if (AMASK & 2) st[1][nt] = __builtin_amdgcn_mfma_f32_16x16x32_bf16(kfr[e % 3], qf[1][ks], st[1][nt], 0, 0, 0);
          __builtin_amdgcn_sched_barrier(0); } }
#undef AT_LDK
    const bool rnone0 = hi[0] < lo[0] || hi[0] < 0 || lo[0] > 63, rnone1 = hi[1] < lo[1] || hi[1] < 0 || lo[1] > 63;
    const bool rcut0 = !rnone0 && !(lo[0] <= 0 && hi[0] >= 63), rcut1 = !rnone1 && !(lo[1] <= 0 && hi[1] >= 63);
    float alpha2[2] = {1.f, 1.f};
    if (!__any(((AMASK & 1) && rcut0) || ((AMASK & 2) && rcut1))) {
#pragma unroll
        for (int a = 0; a < 2; ++a) { if (!(AMASK & (1 << a))) continue; const bool rnone = a ? rnone1 : rnone0;
            float mx = fmaxf(fmaxf(fmaxf(st[a][0][0], st[a][0][1]), fmaxf(st[a][0][2], st[a][0][3])), fmaxf(fmaxf(st[a][1][0], st[a][1][1]), fmaxf(st[a][1][2], st[a][1][3])));
            mx = fmaxf(mx, fmaxf(fmaxf(fmaxf(st[a][2][0], st[a][2][1]), fmaxf(st[a][2][2], st[a][2][3])), fmaxf(fmaxf(st[a][3][0], st[a][3][1]), fmaxf(st[a][3][2], st[a][3][3]))));
            mx = rnone ? -1e30f : mx;
            if (MODE != 1) { mx = fmaxf(mx, xlane(mx, lane ^ 16)); mx = fmaxf(mx, xlane(mx, lane ^ 32)); const float mn = fmaxf(m[a], mx); alpha2[a] = __builtin_amdgcn_exp2f(m[a] - mn); m[a] = mn; }
            const float meff = rnone ? 3e38f : m[a];
            float rs = 0.f;
#pragma unroll
            for (int nt = 0; nt < 4; ++nt)
#pragma unroll
                for (int j = 0; j < 4; ++j) { float p = __builtin_amdgcn_exp2f(st[a][nt][j] - meff); if (MODE == 1) p *= l[a]; st[a][nt][j] = p; rs += p; }
            if (MODE != 1) { rs += xlane(rs, lane ^ 16); rs += xlane(rs, lane ^ 32); l[a] = l[a] * alpha2[a] + rs; } }
    } else {
#pragma unroll
        for (int a = 0; a < 2; ++a) { if (!(AMASK & (1 << a))) continue;
            float mx = -1e30f; const int lo_ = lo[a] - 4 * fq, hi_ = hi[a] - 4 * fq;
#pragma unroll
            for (int nt = 0; nt < 4; ++nt)
#pragma unroll
                for (int j = 0; j < 4; ++j) { const float sv = (16 * nt + j >= lo_ && 16 * nt + j <= hi_) ? st[a][nt][j] : -1e30f; st[a][nt][j] = sv; mx = fmaxf(mx, sv); }
            if (MODE != 1) { mx = fmaxf(mx, xlane(mx, lane ^ 16)); mx = fmaxf(mx, xlane(mx, lane ^ 32)); const float mn = fmaxf(m[a], mx); alpha2[a] = __builtin_amdgcn_exp2f(m[a] - mn); m[a] = mn; }
            float rs = 0.f;
#pragma unroll
            for (int nt = 0; nt < 4; ++nt)
#pragma unroll
                for (int j = 0; j < 4; ++j) { float p = st[a][nt][j] > -5e29f ? __builtin_amdgcn_exp2f(st[a][nt][j] - m[a]) : 0.f; if (MODE == 1) p *= l[a]; st[a][nt][j] = p; rs += p; }
            if (MODE != 1) { rs += xlane(rs, lane ^ 16); rs += xlane(rs, lane ^ 32); l[a] = l[a] * alpha2[a] + rs; } }
    }
    if (MODE == 2) { if (__any(alpha2[0] != 1.f || alpha2[1] != 1.f)) {
#pragma unroll
        for (int dt = 0; dt < 8; ++dt) { O[dt][0] = O[dt][0] * alpha2[0]; O[dt][1] = O[dt][1] * alpha2[1]; } } }
    if (MODE == 0) return;
    bf16x8 pf[2][2];
#pragma unroll
    for (int a = 0; a < 2; ++a)
#pragma unroll
        for (int kk = 0; kk < 2; ++kk) { if (!(AMASK & (1 << a))) continue; const u32x4 w = pack8h(st[a][2 * kk], st[a][2 * kk + 1]); pf[a][kk] = __builtin_bit_cast(bf16x8, w); }
    const int o0 = (fq >> 1) ^ (sw & 3);
    const LAS unsigned char* vrow = Vl + fr * 128 + 8 * (fq & 1);
    const LAS unsigned char* va[2][2] = {{vrow + 64 * swb + 16 * o0, vrow + 64 * swb + 16 * (o0 ^ 2)}, {vrow + 64 * (1 - swb) + 16 * o0, vrow + 64 * (1 - swb) + 16 * (o0 ^ 2)}};
#define AT_LDV(e, dst) do { const u32x2 v0_ = *(const LAS u32x2*)(va[(e) & 1][0] + 2048 * ((e) >> 1)), v1_ = *(const LAS u32x2*)(va[(e) & 1][1] + 2048 * ((e) >> 1)); dst = (u32x4){v0_.x, v0_.y, v1_.x, v1_.y}; } while (0)
    { u32x4 vfr[3]; AT_LDV(0, vfr[0]); AT_LDV(1, vfr[1]);
#pragma unroll
      for (int e = 0; e < 16; ++e) { const int dt = e >> 1, kk = e & 1;
          if (e + 2 < 16) AT_LDV(e + 2, vfr[(e + 2) % 3]);
          const bf16x8 vf = __builtin_bit_cast(bf16x8, vfr[e % 3]);
          if (AMASK & 1) O[dt][0] = __builtin_amdgcn_mfma_f32_16x16x32_bf16(vf, pf[0][kk], O[dt][0], 0, 0, 0);
          if (AMASK & 2) O[dt][1] = __builtin_amdgcn_mfma_f32_16x16x32_bf16(vf, pf[1][kk], O[dt][1], 0, 0, 0);
          __builtin_amdgcn_sched_barrier(0); } }
#undef AT_LDV
    if (MODE == 1) {
#pragma unroll
        for (int a = 0; a < 2; ++a)
#pragma unroll
            for (int nt = 0; nt < 4; ++nt) { f32x4 h = st[a][nt];
#pragma unroll
                for (int j = 0; j < 4; ++j) { h[j] += dpp<0xB1>(h[j]); h[j] += dpp<0x4E>(h[j]); }
                if ((fr & 3) == 0) { const int tl = 4 * a + (fr >> 2), si = sbase + 4 * nt + fq;
                    impA[tl * 64 + si] = (h[0] + h[1]) + (h[2] + h[3]); if (si + 1 < 64) impB[tl * 64 + si + 1] = h[3]; } }
    }
}
struct NsaUnit { int b, g, qi, t0, wave; };
template <int MODE, int KIND>
__device__ __forceinline__ void attn_loop(LAS unsigned char* lds, const NsaUnit& U, int lane, int fr, int fq, const bf16* kbase, const bf16* vbase, int vpitch, int j0, int n,
                                          const int (&tokA)[2], const unsigned long long (&selm)[2], const bf16x8 (&qf)[2][6], float (&m)[2], float (&l)[2], f32x4 (&O)[8][2], LAS float* impA, LAS float* impB) {
    AttnStage stg; at_offsets(stg, U.wave, lane, vpitch);
    at_issue(stg, U.wave, kbase + (size_t)j0 * 64 * 192, vbase + (size_t)j0 * 64, lds + AT_KB, lds + AT_VB);
    asm volatile("s_waitcnt vmcnt(0)" ::: "memory");
    __syncthreads();
    for (int s = 0; s < n; ++s) {
        const int j = j0 + s, bsel = s & 1;
        if (s + 1 < n) at_issue(stg, U.wave, kbase + (size_t)(j + 1) * 64 * 192, vbase + (size_t)(j + 1) * 64, lds + AT_KB + (bsel ^ 1) * AT_KSZ, lds + AT_VB + (bsel ^ 1) * AT_VSZ);
        int lo[2], hi[2];
#pragma unroll
        for (int a = 0; a < 2; ++a) {
            if (KIND == 0) { lo[a] = 0; hi[a] = ((U.t0 + tokA[a] - 31) >> 4) - 64 * j; }
            else if (KIND == 1) { lo[a] = 0; hi[a] = (j == U.qi) ? tokA[a] : (((selm[a] >> j) & 1ull) ? 63 : -1); }
            else { lo[a] = (j == U.qi - 8) ? tokA[a] + 1 : 0; hi[a] = (j == U.qi) ? tokA[a] : 63; }
        }
        if (KIND == 1) { const bool a0 = __any(hi[0] >= 0), a1 = __any(hi[1] >= 0);
            if (a0 && a1) attn_step<MODE, 3>(lds + AT_KB + bsel * AT_KSZ, lds + AT_VB + bsel * AT_VSZ, qf, m, l, O, lo, hi, lane, fr, fq, impA, impB, 16 * j);
            else if (a0) attn_step<MODE, 1>(lds + AT_KB + bsel * AT_KSZ, lds + AT_VB + bsel * AT_VSZ, qf, m, l, O, lo, hi, lane, fr, fq, impA, impB, 16 * j);
            else if (a1) attn_step<MODE, 2>(lds + AT_KB + bsel * AT_KSZ, lds + AT_VB + bsel * AT_VSZ, qf, m, l, O, lo, hi, lane, fr, fq, impA, impB, 16 * j); }
        else attn_step<MODE, 3>(lds + AT_KB + bsel * AT_KSZ, lds + AT_VB + bsel * AT_VSZ, qf, m, l, O, lo, hi, lane, fr, fq, impA, impB, 16 * j);
        asm volatile("s_waitcnt vmcnt(0)" ::: "memory");
        __syncthreads();
    }
}
#define NSA_GATE2(tA_, j) sigmoidf_(LG[(size_t)(U.b * T + U.t0 + (tA_)) * 512 + 448 + (U.g * 4 + (fr2 & 3)) * 3 + (j)])
__device__ __forceinline__ void nsa_cmp_branch(LAS unsigned char* lds, unsigned char* ws, const NsaUnit& U, const bf16x8 (&qf)[2][6]) {
    const int lane = fresh_lane(), fr = lane & 15, fq = lane >> 4;
    int tokA[2]; tokA[0] = 8 * U.wave + (fr >> 2); tokA[1] = tokA[0] + 4;
    LAS float* impA = (LAS float*)(lds + AT_IMPA) + U.wave * 512; LAS float* impB = (LAS float*)(lds + AT_IMPB) + U.wave * 512;
    for (int e = lane; e < 512; e += 64) { impA[e] = 0.f; impB[e] = 0.f; }
    const unsigned long long selm[2] = {0ull, 0ull};
    float m[2], l[2]; f32x4 O[8][2];
    const int nkt = ((4 * U.qi + 2) >> 6) + 1, bg = U.b * 4 + U.g;
    const bf16* kc = (const bf16*)(ws + WS_KCMP) + (size_t)bg * 256 * 192; const bf16* vc = (const bf16*)(ws + WS_VCMT) + (size_t)bg * 256;
    m[0] = m[1] = -1e30f; l[0] = l[1] = 0.f;
    attn_loop<0, 0>(lds, U, lane, fr, fq, kc, vc, 4096, 0, nkt, tokA, selm, qf, m, l, O, impA, impB);
    l[0] = l[0] > 0.f ? 1.f / l[0] : 0.f; l[1] = l[1] > 0.f ? 1.f / l[1] : 0.f;
#pragma unroll
    for (int dt = 0; dt < 8; ++dt) { O[dt][0] = (f32x4){0.f, 0.f, 0.f, 0.f}; O[dt][1] = (f32x4){0.f, 0.f, 0.f, 0.f}; }
    attn_loop<1, 0>(lds, U, lane, fr, fq, kc, vc, 4096, 0, nkt, tokA, selm, qf, m, l, O, impA, impB);
    const float* LG = (const float*)(ws + WS_LG); bf16* YNS = (bf16*)(ws + WS_YNS);
    const int lane2 = fresh_lane(), fr2 = lane2 & 15, fq2 = lane2 >> 4, tB = 8 * U.wave + (fr2 >> 2);
#pragma unroll
    for (int a = 0; a < 2; ++a) { bf16* yp = YNS + (size_t)(U.b * T + U.t0 + tB + 4 * a) * D + (U.g * 4 + (fr2 & 3)) * 128 + 4 * fq2; const float gc = NSA_GATE2(tB + 4 * a, 0);
#pragma unroll
        for (int dt = 0; dt < 8; ++dt) { const f32x4 y = O[dt][a] * gc; u32x2 o; o.x = pk2(y[0], y[1]); o.y = pk2(y[2], y[3]); *(GAS u32x2*)(yp + 16 * dt) = o; } }
}
__device__ __forceinline__ void nsa_topk(LAS unsigned char* lds, const NsaUnit& U) {
    const int lane = fresh_lane();
    LAS float* impA = (LAS float*)(lds + AT_IMPA) + U.wave * 512; LAS float* impB = (LAS float*)(lds + AT_IMPB) + U.wave * 512;
    LAS unsigned long long* masks = (LAS unsigned long long*)(lds + AT_MASK);
    LDS_WAIT(); asm volatile("" ::: "memory");
#pragma unroll 1
    for (int tl = 0; tl < 8; ++tl) {
        const int s_ = lane; const float imp = impA[tl * 64 + s_] + impB[tl * 64 + s_];
        const bool valid = s_ <= U.qi, forced = valid && (s_ == 0 || s_ == U.qi || s_ == U.qi - 1);
        const float sc = forced ? 1e6f : (valid ? imp : -1e30f);
        int rank = 0;
#pragma unroll 8
        for (int o = 0; o < 64; ++o) { const float so = __builtin_bit_cast(float, __builtin_amdgcn_readlane(__builtin_bit_cast(int, sc), o)); rank += (so > sc || (so == sc && o < s_)) ? 1 : 0; }
        const unsigned long long mk = __ballot(rank < 16 && sc > -5e29f);
        if (lane == 0) masks[U.wave * 8 + tl] = mk;
    }
    LDS_WAIT(); asm volatile("" ::: "memory");
}
template <int KIND>
__device__ __forceinline__ void nsa_online_branch(LAS unsigned char* lds, unsigned char* ws, const NsaUnit& U, const bf16x8 (&qf)[2][6]) {
    const int lane = fresh_lane(), fr = lane & 15, fq = lane >> 4;
    int tokA[2]; tokA[0] = 8 * U.wave + (fr >> 2); tokA[1] = tokA[0] + 4;
    LAS float* impA = (LAS float*)(lds + AT_IMPA); LAS float* impB = impA;
    const LAS unsigned long long* masks = (const LAS unsigned long long*)(lds + AT_MASK);
    unsigned long long selm[2]; selm[0] = masks[U.wave * 8 + (fr >> 2)]; selm[1] = masks[U.wave * 8 + 4 + (fr >> 2)];
    float m[2], l[2]; f32x4 O[8][2];
    m[0] = m[1] = -1e30f; l[0] = l[1] = 0.f;
#pragma unroll
    for (int dt = 0; dt < 8; ++dt) { O[dt][0] = (f32x4){0.f, 0.f, 0.f, 0.f}; O[dt][1] = (f32x4){0.f, 0.f, 0.f, 0.f}; }
    const bf16* K3 = (const bf16*)(ws + WS_K3); const bf16* VT = (const bf16*)(ws + WS_VT);
    const int j0 = (KIND == 2 && U.qi >= 8) ? U.qi - 8 : 0;
    attn_loop<2, KIND>(lds, U, lane, fr, fq, K3 + (size_t)((KIND * 4 + U.b) * 4 + U.g) * T * 192, VT + (size_t)((KIND - 1) * 512 + U.g * 128) * M + (size_t)U.b * T, M, j0, U.qi - j0 + 1,
                       tokA, selm, qf, m, l, O, impA, impB);
    const float* LG = (const float*)(ws + WS_LG); bf16* YNS = (bf16*)(ws + WS_YNS);
    const int lane2 = fresh_lane(), fr2 = lane2 & 15, fq2 = lane2 >> 4, tB = 8 * U.wave + (fr2 >> 2);
#pragma unroll
    for (int a = 0; a < 2; ++a) { const size_t off = (size_t)(U.b * T + U.t0 + tB + 4 * a) * D + (U.g * 4 + (fr2 & 3)) * 128 + 4 * fq2; const float sc = l[a] > 0.f ? NSA_GATE2(tB + 4 * a, KIND) / l[a] : 0.f;
#pragma unroll
        for (int dt = 0; dt < 8; ++dt) { const u32x2 pv = *(const GAS u32x2*)(YNS + off + 16 * dt); const f32x4 y = (f32x4){bflo(pv.x), bfhi(pv.x), bflo(pv.y), bfhi(pv.y)} + O[dt][a] * sc;
            u32x2 o; o.x = pk2(y[0], y[1]); o.y = pk2(y[2], y[3]); *(GAS u32x2*)(YNS + off + 16 * dt) = o; } }
}
__device__ __forceinline__ void phase_nsa_attn(int wv) {
    const Frame F = mkframe(wv); unsigned char* ws = wsptr(F);
#pragma unroll 1
    for (int r = 0; r < 4; ++r) {
        const int q = r * F.G + F.bx; if (q >= 1024) break;
        const int bg = q >> 6, ii = q & 63;
        NsaUnit U; U.qi = (r & 1) ? 63 - ii : ii; U.b = bg >> 2; U.g = bg & 3; U.t0 = 64 * U.qi; U.wave = F.wave;
        bf16x8 qf[2][6];
        { const int lane = fresh_lane(), fr = lane & 15, fq = lane >> 4; const bf16* QB = (const bf16*)(ws + WS_QB);
#pragma unroll
          for (int a = 0; a < 2; ++a)
#pragma unroll
            for (int ks = 0; ks < 6; ++ks) qf[a][ks] = *(const GAS bf16x8*)(QB + (size_t)(U.b * T + U.t0 + 8 * U.wave + 4 * a + (fr >> 2)) * 3072 + (U.g * 4 + (fr & 3)) * 192 + 32 * ks + 8 * fq); }
        nsa_cmp_branch(F.lds, ws, U, qf);
        nsa_topk(F.lds, U);
        nsa_online_branch<1>(F.lds, ws, U, qf);
        nsa_online_branch<2>(F.lds, ws, U, qf);
    }
}

template <int Q> __device__ __forceinline__ float fmac_qb(float acc, float x, float s) {
    if (Q == 0) asm("v_fmac_f32_dpp %0, %1, %2 quad_perm:[0,0,0,0] row_mask:0xf bank_mask:0xf" : "+v"(acc) : "v"(x), "v"(s));
    else if (Q == 1) asm("v_fmac_f32_dpp %0, %1, %2 quad_perm:[1,1,1,1] row_mask:0xf bank_mask:0xf" : "+v"(acc) : "v"(x), "v"(s));
    else if (Q == 2) asm("v_fmac_f32_dpp %0, %1, %2 quad_perm:[2,2,2,2] row_mask:0xf bank_mask:0xf" : "+v"(acc) : "v"(x), "v"(s));
    else asm("v_fmac_f32_dpp %0, %1, %2 quad_perm:[3,3,3,3] row_mask:0xf bank_mask:0xf" : "+v"(acc) : "v"(x), "v"(s));
    return acc;
}
template <int Q> __device__ __forceinline__ float mul_qb(float x, float s) {
    float d;
    if (Q == 0) asm("v_mul_f32_dpp %0, %1, %2 quad_perm:[0,0,0,0] row_mask:0xf bank_mask:0xf" : "=v"(d) : "v"(x), "v"(s));
    else if (Q == 1) asm("v_mul_f32_dpp %0, %1, %2 quad_perm:[1,1,1,1] row_mask:0xf bank_mask:0xf" : "=v"(d) : "v"(x), "v"(s));
    else if (Q == 2) asm("v_mul_f32_dpp %0, %1, %2 quad_perm:[2,2,2,2] row_mask:0xf bank_mask:0xf" : "=v"(d) : "v"(x), "v"(s));
    else asm("v_mul_f32_dpp %0, %1, %2 quad_perm:[3,3,3,3] row_mask:0xf bank_mask:0xf" : "=v"(d) : "v"(x), "v"(s));
    return d;
}
template <int HI> __device__ __forceinline__ float fmix(unsigned hp, float s, float acc) { float d;
    if (HI) asm("v_fma_mix_f32 %0, %1, %2, %3 op_sel:[1,0,0] op_sel_hi:[1,0,0]" : "=v"(d) : "v"(hp), "v"(s), "v"(acc));
    else asm("v_fma_mix_f32 %0, %1, %2, %3 op_sel_hi:[1,0,0]" : "=v"(d) : "v"(hp), "v"(s), "v"(acc));
    return d; }
__device__ __forceinline__ float allreduce8(float x) { x += dpp<0xB1>(x); x += dpp<0x4E>(x); x += dpp<0x141>(x); return x; }
__device__ __forceinline__ void phase_rw_e1(int wv, int l) {
    const Frame F = mkframe(wv); unsigned char* ws = wsptr(F); const int lane = F.lane;
    const float* LG = (const float*)(ws + WS_LG); const bf16* RKV = (const bf16*)(ws + WS_RKV); bf16* AL = (bf16*)(ws + WS_AL); bf16* VS = (bf16*)(ws + (l ? WS_VS1 : WS_VS0));
    const float* mu = inptr(F, 2) + (size_t)l * 6592;
    for (int row = F.vcu * NWAVES + F.wave; row < M; row += F.G * NWAVES) {
        const bool first = (row & (T - 1)) == 0;
        { f32x4 o0 = (f32x4){0.f, 0.f, 0.f, 0.f}, o1 = o0;
          if (lane < 24 || lane >= 32) { const int sc = lane < 24 ? 8 * lane : 8 * lane - 64;
              const f32x4 c0 = *(const GAS f32x4*)(LG + (size_t)row * 512 + sc), c1 = *(const GAS f32x4*)(LG + (size_t)row * 512 + sc + 4);
              f32x4 p0 = (f32x4){0.f, 0.f, 0.f, 0.f}, p1 = p0; if (!first) { p0 = *(const GAS f32x4*)(LG + (size_t)(row - 1) * 512 + sc); p1 = *(const GAS f32x4*)(LG + (size_t)(row - 1) * 512 + sc + 4); }
              const f32x4 m0 = *(const GAS f32x4*)(mu + 6144 + sc), m1 = *(const GAS f32x4*)(mu + 6144 + sc + 4);
              o0 = c0 + (p0 - c0) * m0; o1 = c1 + (p1 - c1) * m1;
              if (lane < 12) {
#pragma unroll
                  for (int j = 0; j < 4; ++j) { o0[j] = 1.f - 2.f / (1.f + __expf(2.f * o0[j])); o1[j] = 1.f - 2.f / (1.f + __expf(2.f * o1[j])); } }
              else if (lane >= 32) {
#pragma unroll
                  for (int j = 0; j < 4; ++j) { o0[j] = sigmoidf_(o0[j]); o1[j] = sigmoidf_(o1[j]); } } }
          *(GAS u32x4*)(AL + (size_t)row * 512 + 8 * lane) = pack8(o0, o1); }
#pragma unroll
        for (int i = 0; i < 4; ++i) { const int c = 8 * lane + 512 * i; f32x4 c0, c1, p0 = (f32x4){0.f, 0.f, 0.f, 0.f}, p1 = p0;
            unpack8(*(const GAS u32x4*)(RKV + (size_t)row * 6144 + 4096 + c), c0, c1);
            if (!first) unpack8(*(const GAS u32x4*)(RKV + (size_t)(row - 1) * 6144 + 4096 + c), p0, p1);
            const f32x4 m0 = *(const GAS f32x4*)(mu + 4096 + c), m1 = *(const GAS f32x4*)(mu + 4096 + c + 4);
            *(GAS u32x4*)(VS + (size_t)row * D + c) = pack8(c0 + (p0 - c0) * m0, c1 + (p1 - c1) * m1); }
    }
}
constexpr int SC_R = 0, SC_W = 4096, SC_K = 8192, SC_A = 12288, SC_B = 16384, SC_V = 20480, SC_BUF = 24576;
typedef _Float16 h16x8 __attribute__((ext_vector_type(8)));
#define SC_BARRIER() do { asm volatile("s_waitcnt lgkmcnt(0)" ::: "memory"); __builtin_amdgcn_s_barrier(); asm volatile("" ::: "memory"); } while (0)
__device__ __forceinline__ void phase_scan(int wv, int l) {
    const Frame F = mkframe(wv); unsigned char* ws = wsptr(F); const int lane = F.lane, wave = F.wave;
    const bf16* RKV = (const bf16*)(ws + WS_RKV); const bf16* VS = (const bf16*)(ws + (l ? WS_VS1 : WS_VS0)); const float* DEC = (const float*)(ws + WS_DEC); const bf16* AG = (const bf16*)(ws + WS_AG);
    float* YR = (float*)(ws + WS_YR); float* BON = (float*)(ws + WS_BON);
    const float* mu = inptr(F, 2) + (size_t)l * 6592; const float* kkp = inptr(F, 11) + (size_t)l * D; const float* kap = inptr(F, 12) + (size_t)l * D; const float* rkp = inptr(F, 13) + (size_t)l * D;
    for (int uid = F.bx; uid < 256; uid += F.G) {
        const int b = uid >> 6, h = (uid >> 1) & 31, half = uid & 1;
        if (wave >= 4) {
            const int ht = (wave - 4) * 64 + lane, t = ht >> 3, cg = ht & 7, ch = h * 64 + 8 * cg;
            f32x4 mr0 = *(const GAS f32x4*)(mu + ch), mr1 = *(const GAS f32x4*)(mu + ch + 4), mk0 = *(const GAS f32x4*)(mu + 2048 + ch), mk1 = *(const GAS f32x4*)(mu + 2048 + ch + 4);
            f32x4 kk0 = *(const GAS f32x4*)(kkp + ch), kk1 = *(const GAS f32x4*)(kkp + ch + 4), ka0 = *(const GAS f32x4*)(kap + ch), ka1 = *(const GAS f32x4*)(kap + ch + 4);
            f32x4 rk0 = *(const GAS f32x4*)(rkp + ch), rk1 = *(const GAS f32x4*)(rkp + ch + 4);
#define HL_LOAD(P, cn_) do { const int tt_ = 32 * (cn_) + t; const size_t tk_ = (size_t)b * T + tt_; \
        P##rc = *(const GAS u32x4*)(RKV + tk_ * 6144 + ch); P##kc = *(const GAS u32x4*)(RKV + tk_ * 6144 + 2048 + ch); \
        if (tt_ > 0) { P##rp = *(const GAS u32x4*)(RKV + (tk_ - 1) * 6144 + ch); P##kp = *(const GAS u32x4*)(RKV + (tk_ - 1) * 6144 + 2048 + ch); } else { P##rp = (u32x4){0u, 0u, 0u, 0u}; P##kp = P##rp; } \
        P##vv = *(const GAS u32x4*)(VS + tk_ * D + ch); P##ag = *(const GAS u32x4*)(AG + tk_ * D + ch); \
        P##d0 = *(const GAS f32x4*)(DEC + tk_ * D + ch); P##d1 = *(const GAS f32x4*)(DEC + tk_ * D + ch + 4); } while (0)
#define H8(x0, x1) (h16x8){(_Float16)x0[0], (_Float16)x0[1], (_Float16)x0[2], (_Float16)x0[3], (_Float16)x1[0], (_Float16)x1[1], (_Float16)x1[2], (_Float16)x1[3]}
#define HL_PROC(P, cn_) do { LAS unsigned char* sb = F.lds + ((cn_) & 1) * SC_BUF; const size_t token = (size_t)b * T + 32 * (cn_) + t; \
        f32x4 r0, r1, k0, k1, v0, v1, a0, a1, p0, p1, q0, q1; unpack8(P##rc, r0, r1); unpack8(P##kc, k0, k1); unpack8(P##rp, p0, p1); unpack8(P##kp, q0, q1); unpack8(P##vv, v0, v1); unpack8(P##ag, a0, a1); \
        const f32x4 d0 = P##d0, d1 = P##d1; \
        r0 = r0 + (p0 - r0) * mr0; r1 = r1 + (p1 - r1) * mr1; k0 = k0 + (q0 - k0) * mk0; k1 = k1 + (q1 - k1) * mk1; \
        f32x4 n0 = k0 * kk0, n1 = k1 * kk1; \
        float ss = (n0[0] * n0[0] + n0[1] * n0[1]) + (n0[2] * n0[2] + n0[3] * n0[3]) + (n1[0] * n1[0] + n1[1] * n1[1]) + (n1[2] * n1[2] + n1[3] * n1[3]); \
        ss = allreduce8(ss); const float inv = 1.0f / sqrtf(fmaxf(ss, 1e-24f)); n0 = n0 * inv; n1 = n1 * inv; \
        const f32x4 k20 = k0 * (1.0f + (a0 - 1.0f) * ka0), k21 = k1 * (1.0f + (a1 - 1.0f) * ka1); \
        float bo = (r0[0] * k20[0] * rk0[0] + r0[1] * k20[1] * rk0[1]) + (r0[2] * k20[2] * rk0[2] + r0[3] * k20[3] * rk0[3]) + (r1[0] * k21[0] * rk1[0] + r1[1] * k21[1] * rk1[1]) + (r1[2] * k21[2] * rk1[2] + r1[3] * k21[3] * rk1[3]); \
        bo = allreduce8(bo); if (half == 0 && cg == 0) BON[token * 32 + h] = bo; \
        { const int ho = (t * 64 + 8 * cg) * 2; const f32x4 wm0 = d0 - 1.0f, wm1 = d1 - 1.0f, na0 = -n0, na1 = -n1, nb0 = n0 * a0, nb1 = n1 * a1; \
          *(LAS h16x8*)(sb + SC_R + ho) = H8(r0, r1); *(LAS h16x8*)(sb + SC_W + ho) = H8(wm0, wm1); *(LAS h16x8*)(sb + SC_K + ho) = H8(k20, k21); \
          *(LAS h16x8*)(sb + SC_A + ho) = H8(na0, na1); *(LAS h16x8*)(sb + SC_B + ho) = H8(nb0, nb1); } \
        if ((cg >> 2) == half) { LAS f32x4* pv = (LAS f32x4*)(sb + SC_V + (t * 32 + 8 * (cg & 3)) * 4); pv[0] = v0; pv[1] = v1; } \
        LDS_WAIT(); SC_BARRIER(); } while (0)
            u32x4 Arc, Arp, Akc, Akp, Avv, Aag, Brc, Brp, Bkc, Bkp, Bvv, Bag; f32x4 Ad0, Ad1, Bd0, Bd1;
            HL_LOAD(A, 0);
            for (int cn = 0; cn < 128; cn += 2) {
                HL_LOAD(B, cn + 1);
                HL_PROC(A, cn);
                if (cn + 2 < 128) HL_LOAD(A, cn + 2);
                HL_PROC(B, cn + 1);
            }
#undef HL_LOAD
#undef HL_PROC
#undef H8
            SC_BARRIER();
        } else {
            const int il = lane >> 3, s_ = lane & 7, rloc = 8 * wave + il, irow = half * 32 + rloc;
            float S[8];
#pragma unroll
            for (int j = 0; j < 8; ++j) S[j] = 0.f;
            const int voff = 16 * s_;
            SC_BARRIER();
#define SC_LOAD(P, t_) do { const int o_ = (t_) * 128 + voff; P##a = *(const LAS u32x4*)(sb + SC_A + o_); P##w = *(const LAS u32x4*)(sb + SC_W + o_); P##b = *(const LAS u32x4*)(sb + SC_B + o_); \
        P##k = *(const LAS u32x4*)(sb + SC_K + o_); P##r = *(const LAS u32x4*)(sb + SC_R + o_); P##v = *(const LAS float*)(sb + SC_V + (t_) * 128 + rloc * 4); } while (0)
#define SC_STEP(P, t_) do { float sa0 = 0.f, sa1 = 0.f; \
        _Pragma("unroll") for (int j = 0; j < 4; ++j) { sa0 = fmix<0>(P##a[j], S[2 * j], sa0); sa1 = fmix<1>(P##a[j], S[2 * j + 1], sa1); } \
        const float sa = allreduce8(sa0 + sa1); \
        _Pragma("unroll") for (int j = 0; j < 4; ++j) { float x0 = fmix<0>(P##w[j], S[2 * j], S[2 * j]), x1 = fmix<1>(P##w[j], S[2 * j + 1], S[2 * j + 1]); \
            x0 = fmix<0>(P##b[j], sa, x0); x1 = fmix<1>(P##b[j], sa, x1); S[2 * j] = fmix<0>(P##k[j], P##v, x0); S[2 * j + 1] = fmix<1>(P##k[j], P##v, x1); } \
        float y0 = 0.f, y1 = 0.f; \
        _Pragma("unroll") for (int j = 0; j < 4; ++j) { y0 = fmix<0>(P##r[j], S[2 * j], y0); y1 = fmix<1>(P##r[j], S[2 * j + 1], y1); } \
        const float y = allreduce8(y0 + y1); if (s_ == 0) yp[(size_t)(t_) * D] = y; } while (0)
            for (int c = 0; c < 128; ++c) {
                const LAS unsigned char* sb = F.lds + (c & 1) * SC_BUF;
                float* yp = YR + ((size_t)b * T + 32 * c) * D + h * 64 + irow;
                u32x4 Aa, Aw, Ab, Ak, Ar, Ba, Bw, Bb, Bk, Br; float Av, Bv;
                SC_LOAD(A, 0);
                for (int t = 0; t < 32; t += 2) {
                    SC_LOAD(B, t + 1);
                    SC_STEP(A, t);
                    if (t + 2 < 32) SC_LOAD(A, t + 2);
                    SC_STEP(B, t + 1);
                }
                SC_BARRIER();
            }
#undef SC_LOAD
#undef SC_STEP
        }
    }
}
__device__ __forceinline__ float wave_sum_u(float v) {
    v += dpp<0xB1>(v); v += dpp<0x4E>(v); v += dpp<0x141>(v); v += dpp<0x140>(v);
    v += __builtin_bit_cast(float, __builtin_amdgcn_update_dpp(0, __builtin_bit_cast(int, v), 0x142, 0xa, 0xf, false));
    v += __builtin_bit_cast(float, __builtin_amdgcn_update_dpp(0, __builtin_bit_cast(int, v), 0x143, 0xc, 0xf, false));
    return __builtin_bit_cast(float, __builtin_amdgcn_readlane(__builtin_bit_cast(int, v), 63));
}
constexpr int CK_XA = 0, CK_XR = 2304, CK_XB = 4608, CK_XK = 6912, CK_AT = 9216, CK_VT = 11264, CK_TB = 13312, CK_GC = 13824, CK_WAVE = 14336, CK_STATE = 8 * CK_WAVE;
static_assert(CK_STATE + 16384 <= RING_BYTES, "chunked-scan LDS");
__device__ __forceinline__ u32x2 pk4(const f32x4 v) { u32x2 r; r.x = pk2h(v[0], v[1]); r.y = pk2h(v[2], v[3]); return r; }
__device__ __forceinline__ bf16x8 frag2(const u32x2 lo, const u32x2 hi) { const u32x4 w = (u32x4){lo.x, lo.y, hi.x, hi.y}; return __builtin_bit_cast(bf16x8, w); }
__device__ __forceinline__ bf16x8 frag1(const u32x2 lo) { const u32x4 w = (u32x4){lo.x, lo.y, 0u, 0u}; return __builtin_bit_cast(bf16x8, w); }
#define MFMA16(a, b, c) __builtin_amdgcn_mfma_f32_16x16x32_bf16(a, b, c, 0, 0, 0)
__device__ __forceinline__ void phase_scan_chunked(int wv, int l) {
    const Frame F = mkframe(wv); unsigned char* ws = wsptr(F); const int lane = F.lane, wave = F.wave, fr0 = lane & 15, fq0 = lane >> 4;
    const bf16* RKV = (const bf16*)(ws + WS_RKV); const bf16* VS = (const bf16*)(ws + (l ? WS_VS1 : WS_VS0)); const float* DEC = (const float*)(ws + WS_DEC); const bf16* AG = (const bf16*)(ws + WS_AG);
    float* YR = (float*)(ws + WS_YR); float* BON = (float*)(ws + WS_BON);
    const float* mu = inptr(F, 2) + (size_t)l * 6592; const float* kkp = inptr(F, 11) + (size_t)l * D; const float* kap = inptr(F, 12) + (size_t)l * D; const float* rkp = inptr(F, 13) + (size_t)l * D;
    LAS unsigned char* P = F.lds + wave * CK_WAVE;
    LAS unsigned char* STB = F.lds + CK_STATE;
    volatile LAS int* flag = (volatile LAS int*)(F.lds + MISC_OFF + 64);
    for (int uid = F.bx; uid < 128; uid += F.G) {
        const int b = uid >> 5, h = uid & 31, ch = h * 64 + lane;
        if (F.tid == 0) *flag = 0;
        for (int e = F.tid; e < 4096; e += NTHR) ((LAS float*)STB)[e] = 0.f;
        SC_BARRIER();
        const float mur = mu[ch], muk = mu[2048 + ch], kkj = kkp[ch], kaj = kap[ch], rkj = rkp[ch];
        unsigned short qr[16], qk[16], qv[16], qa[16], qrp = 0, qkp = 0; float qd[16];
#define CK_LOAD(t0_, hasprev_) do { const size_t t0__ = (t0_); _Pragma("unroll") for (int t = 0; t < 16; ++t) { const size_t tk = t0__ + t; qr[t] = RKV[tk * 6144 + ch]; qk[t] = RKV[tk * 6144 + 2048 + ch]; \
            qv[t] = VS[tk * D + ch]; qa[t] = AG[tk * D + ch]; qd[t] = DEC[tk * D + ch]; } \
        if (hasprev_) { qrp = RKV[(t0__ - 1) * 6144 + ch]; qkp = RKV[(t0__ - 1) * 6144 + 2048 + ch]; } } while (0)
        CK_LOAD((size_t)b * T + 16 * wave, wave > 0);
        for (int c = wave; c < 256; c += 8) {
            const size_t tok0 = (size_t)b * T + 16 * c;
            int fr = fr0, fq = fq0; asm volatile("" : "+v"(fr), "+v"(fq));
            float rr[16], kr[16], vv[16], ga[16], dc[16];
#pragma unroll
            for (int t = 0; t < 16; ++t) { rr[t] = bf2f(qr[t]); kr[t] = bf2f(qk[t]); vv[t] = bf2f(qv[t]); ga[t] = bf2f(qa[t]); dc[t] = qd[t]; }
            const float rp = bf2f(qrp), kp = bf2f(qkp);
            float G = 1.0f; float bh[16], kh[16];
            { u32x4 vt0, vt1; unsigned vw[8];
#pragma unroll
              for (int t = 0; t < 16; t += 2) vw[t >> 1] = pk2h(vv[t], vv[t + 1]);
              vt0 = (u32x4){vw[0], vw[1], vw[2], vw[3]}; vt1 = (u32x4){vw[4], vw[5], vw[6], vw[7]};
              *(LAS u32x4*)(P + CK_VT + lane * 32) = vt0; *(LAS u32x4*)(P + CK_VT + lane * 32 + 16) = vt1; }
            unsigned atw[8]; float atprev = 0.f;
#pragma unroll
            for (int t = 0; t < 16; ++t) {
                const float rs = rr[t] + ((t ? rr[t - 1] : rp) - rr[t]) * mur, ks = kr[t] + ((t ? kr[t - 1] : kp) - kr[t]) * muk;
                const float kk = ks * kkj; const float ss = wave_sum_u(kk * kk); const float kn = kk * __builtin_amdgcn_rsqf(fmaxf(ss, 1e-24f));
                const float k2 = ks * (1.0f + (ga[t] - 1.0f) * kaj);
                const float bo = wave_sum_u(rs * k2 * rkj); if (lane == 0) BON[(tok0 + t) * 32 + h] = bo;
                const float Gp = G; G *= dc[t]; const float iG = __builtin_amdgcn_rcpf(G);
                const float at = -kn * Gp, rt = rs * G; bh[t] = kn * ga[t] * iG; kh[t] = k2 * iG;
                *(LAS unsigned short*)(P + CK_XA + t * 144 + lane * 2) = (unsigned short)pk2h(at, at);
                *(LAS unsigned short*)(P + CK_XR + t * 144 + lane * 2) = (unsigned short)pk2h(rt, rt);
                *(LAS unsigned short*)(P + CK_XB + t * 144 + lane * 2) = (unsigned short)pk2h(bh[t], bh[t]);
                *(LAS unsigned short*)(P + CK_XK + t * 144 + lane * 2) = (unsigned short)pk2h(kh[t], kh[t]);
                if (t & 1) atw[t >> 1] = pk2h(atprev, at); atprev = at;
            }
            *(LAS u32x4*)(P + CK_AT + lane * 32) = (u32x4){atw[0], atw[1], atw[2], atw[3]}; *(LAS u32x4*)(P + CK_AT + lane * 32 + 16) = (u32x4){atw[4], atw[5], atw[6], atw[7]};
            *(LAS float*)(P + CK_GC + lane * 4) = G;
            LDS_WAIT(); asm volatile("" ::: "memory");
            const f32x4 Z4 = (f32x4){0.f, 0.f, 0.f, 0.f};
            f32x4 m1 = Z4, m2t = Z4, m3t = Z4, m4t = Z4;
#pragma unroll
            for (int ks = 0; ks < 2; ++ks) { const int o = fr * 144 + (32 * ks + 8 * fq) * 2;
                const bf16x8 fa = *(const LAS bf16x8*)(P + CK_XA + o), frr = *(const LAS bf16x8*)(P + CK_XR + o), fb = *(const LAS bf16x8*)(P + CK_XB + o), fk = *(const LAS bf16x8*)(P + CK_XK + o);
                m1 = MFMA16(fa, fb, m1);
                m2t = MFMA16(fk, fa, m2t);
                m3t = MFMA16(fb, frr, m3t);
                m4t = MFMA16(fk, frr, m4t); }
#pragma unroll
            for (int r = 0; r < 4; ++r) { const int q = 4 * fq + r; if (!(fr < q)) m1[r] = 0.f; if (!(q < fr)) m2t[r] = 0.f; if (!(q <= fr)) { m3t[r] = 0.f; m4t[r] = 0.f; } }
            float Tr[16]; const int cc = fr;
            int m1r[4];
#pragma unroll
            for (int r = 0; r < 4; ++r) { const float e_ = m1[r]; m1r[r] = __builtin_bit_cast(int, e_); }
#pragma unroll
            for (int t = 0; t < 16; ++t) { float acc = (cc == t) ? 1.0f : 0.f;
#pragma unroll
                for (int s2 = 0; s2 < t; ++s2) { const float m = __builtin_bit_cast(float, __builtin_amdgcn_readlane(m1r[t & 3], (t >> 2) * 16 + s2)); acc = __builtin_fmaf(m, Tr[s2], acc); }
                Tr[t] = acc; __builtin_amdgcn_sched_barrier(0); }
            if (lane < 16) {
#pragma unroll
                for (int t = 0; t < 16; ++t) *(LAS unsigned short*)(P + CK_TB + t * 32 + lane * 2) = (unsigned short)pk2h(Tr[t], Tr[t]); }
            { unsigned bw[8], kw[8];
#pragma unroll
              for (int t = 0; t < 16; t += 2) { bw[t >> 1] = pk2h(bh[t] * G, bh[t + 1] * G); kw[t >> 1] = pk2h(kh[t] * G, kh[t + 1] * G); }
              LDS_WAIT(); asm volatile("" ::: "memory");
              *(LAS u32x4*)(P + CK_XB + lane * 32) = (u32x4){bw[0], bw[1], bw[2], bw[3]}; *(LAS u32x4*)(P + CK_XB + lane * 32 + 16) = (u32x4){bw[4], bw[5], bw[6], bw[7]};
              *(LAS u32x4*)(P + CK_XK + lane * 32) = (u32x4){kw[0], kw[1], kw[2], kw[3]}; *(LAS u32x4*)(P + CK_XK + lane * 32 + 16) = (u32x4){kw[4], kw[5], kw[6], kw[7]}; }
            LDS_WAIT(); asm volatile("" ::: "memory");
            const bf16x8 Tf = frag1(*(const LAS u32x2*)(P + CK_TB + fr * 32 + 8 * fq));
            const bf16x8 M2f = frag1(pk4(m2t)), M34f = frag2(pk4(m3t), pk4(m4t)), M3f = frag1(pk4(m3t));
#pragma unroll
            for (int jt = 0; jt < 4; ++jt) {
                const bf16x8 atf = frag1(*(const LAS u32x2*)(P + CK_AT + (16 * jt + fr) * 32 + 8 * fq));
                const f32x4 ah = MFMA16(Tf, atf, Z4);
                const f32x4 aht = MFMA16(atf, Tf, Z4);
                LAS u32x2* rq = (LAS u32x2*)(P + CK_XR + fr * 144 + (16 * jt + 4 * fq) * 2);
                const u32x2 rw = *rq; const f32x4 rinit = (f32x4){bflo(rw.x), bfhi(rw.x), bflo(rw.y), bfhi(rw.y)};
                const f32x4 rht = MFMA16(frag1(pk4(ah)), M3f, rinit);
                *(LAS u32x2*)(P + CK_XA + fr * 144 + (16 * jt + 4 * fq) * 2) = pk4(aht);
                *rq = pk4(rht); }
            f32x4 W2[4], Y0[4]; u32x2 vtf[4];
#pragma unroll
            for (int it = 0; it < 4; ++it) { vtf[it] = *(const LAS u32x2*)(P + CK_VT + (16 * it + fr) * 32 + 8 * fq);
                const f32x4 x = MFMA16(M2f, frag1(vtf[it]), Z4);
                W2[it] = MFMA16(Tf, frag1(pk4(x)), Z4);
                Y0[it] = MFMA16(M34f, frag2(pk4(W2[it]), vtf[it]), Z4); }
            LDS_WAIT(); asm volatile("" ::: "memory");
            { int spins = 0; while (*flag < c) { if (++spins > (1 << 27)) break; } }
            asm volatile("" ::: "memory");
            __builtin_amdgcn_s_setprio(3);
            f32x4 St[4][4];
#pragma unroll
            for (int jt = 0; jt < 4; ++jt)
#pragma unroll
                for (int it = 0; it < 4; ++it) St[jt][it] = *(const LAS f32x4*)(STB + (jt * 4 + it) * 1024 + lane * 16);
            f32x4 U[4]; bf16x8 sb[2][4];
#pragma unroll
            for (int it = 0; it < 4; ++it) { U[it] = W2[it];
#pragma unroll
                for (int ks = 0; ks < 2; ++ks) sb[ks][it] = frag2(pk4(St[2 * ks][it]), pk4(St[2 * ks + 1][it])); }
#pragma unroll
            for (int ks = 0; ks < 2; ++ks) {
                const bf16x8 af = frag2(*(const LAS u32x2*)(P + CK_XA + fr * 144 + (32 * ks + 4 * fq) * 2), *(const LAS u32x2*)(P + CK_XA + fr * 144 + (32 * ks + 16 + 4 * fq) * 2));
#pragma unroll
                for (int it = 0; it < 4; ++it) U[it] = MFMA16(af, sb[ks][it], U[it]); }
#pragma unroll
            for (int jt = 0; jt < 4; ++jt) {
                const bf16x8 bkf = frag2(*(const LAS u32x2*)(P + CK_XB + (16 * jt + fr) * 32 + 8 * fq), *(const LAS u32x2*)(P + CK_XK + (16 * jt + fr) * 32 + 8 * fq));
                const f32x4 gc = *(const LAS f32x4*)(P + CK_GC + (16 * jt + 4 * fq) * 4);
#pragma unroll
                for (int it = 0; it < 4; ++it) { const f32x4 sn = MFMA16(bkf, frag2(pk4(U[it]), vtf[it]), St[jt][it] * gc);
                    *(LAS f32x4*)(STB + (jt * 4 + it) * 1024 + lane * 16) = sn; } }
            LDS_WAIT(); asm volatile("" ::: "memory");
            if (lane == 0) *flag = c + 1;
            asm volatile("" ::: "memory");
            __builtin_amdgcn_s_setprio(0);
            CK_LOAD((c + 8 < 256) ? tok0 + 128 : tok0, true);
            f32x4 Yv[4];
#pragma unroll
            for (int it = 0; it < 4; ++it) Yv[it] = Y0[it];
#pragma unroll
            for (int ks = 0; ks < 2; ++ks) {
                const bf16x8 rf = frag2(*(const LAS u32x2*)(P + CK_XR + fr * 144 + (32 * ks + 4 * fq) * 2), *(const LAS u32x2*)(P + CK_XR + fr * 144 + (32 * ks + 16 + 4 * fq) * 2));
#pragma unroll
                for (int it = 0; it < 4; ++it) Yv[it] = MFMA16(rf, sb[ks][it], Yv[it]); }
#pragma unroll
            for (int it = 0; it < 4; ++it)
#pragma unroll
                for (int r = 0; r < 4; ++r) { const float yv_ = Yv[it][r]; ((GAS unsigned short*)YR)[(tok0 + 4 * fq + r) * D + h * 64 + 16 * it + fr] = (unsigned short)pk2h(yv_, yv_); }
        }
#undef CK_LOAD
        SC_BARRIER();
    }
}

__device__ __forceinline__ float row_sum16(float v) { v += dpp<0xB1>(v); v += dpp<0x4E>(v); v += dpp<0x141>(v); v += dpp<0x140>(v); return v; }
__device__ __forceinline__ void phase_rw_e3(int wv, int l) {
    const Frame F = mkframe(wv); unsigned char* ws = wsptr(F); const int lane = F.lane;
    const bf16* YR = (const bf16*)(ws + WS_YR); const float* BON = (const float*)(ws + WS_BON); const bf16* VS = (const bf16*)(ws + (l ? WS_VS1 : WS_VS0)); const bf16* GG = (const bf16*)(ws + WS_GG); bf16* YRW = (bf16*)(ws + WS_YRW);
    const float* gng = inptr(F, 14) + (size_t)l * D; const float* gnb = inptr(F, 15) + (size_t)l * D;
    const int NGW = F.G * NWAVES;
    for (int row0 = F.vcu * NWAVES + F.wave; row0 < M; row0 += 2 * NGW) {
        u32x4 yr[2][4], vr[2][4], gr[2][4];
#pragma unroll
        for (int r = 0; r < 2; ++r) { const int row = min(row0 + r * NGW, M - 1);
#pragma unroll
            for (int j = 0; j < 4; ++j) { yr[r][j] = ((const GAS u32x4*)(YR + (size_t)row * D))[64 * j + lane]; vr[r][j] = ((const GAS u32x4*)(VS + (size_t)row * D))[64 * j + lane]; gr[r][j] = ((const GAS u32x4*)(GG + (size_t)row * D))[64 * j + lane]; } }
#pragma unroll
        for (int r = 0; r < 2; ++r) { const int row = row0 + r * NGW; if (row >= M) break;
#pragma unroll
            for (int j = 0; j < 4; ++j) {
                const f32x4 w0 = ((const GAS f32x4*)gng)[128 * j + 2 * lane], w1 = ((const GAS f32x4*)gng)[128 * j + 2 * lane + 1], b0 = ((const GAS f32x4*)gnb)[128 * j + 2 * lane], b1 = ((const GAS f32x4*)gnb)[128 * j + 2 * lane + 1];
                const float bo = BON[(size_t)row * 32 + 8 * j + (lane >> 3)];
                f32x4 t0, t1, v0, v1, g0, g1; unpack8(yr[r][j], t0, t1); unpack8(vr[r][j], v0, v1); unpack8(gr[r][j], g0, g1);
                const float mean = allreduce8(((t0[0] + t0[1]) + (t0[2] + t0[3])) + ((t1[0] + t1[1]) + (t1[2] + t1[3]))) * (1.f / 64.f);
                t0 = t0 - mean; t1 = t1 - mean;
                const float rstd = 1.0f / sqrtf(allreduce8(((t0[0] * t0[0] + t0[1] * t0[1]) + (t0[2] * t0[2] + t0[3] * t0[3])) + ((t1[0] * t1[0] + t1[1] * t1[1]) + (t1[2] * t1[2] + t1[3] * t1[3]))) * (1.f / 64.f) + 64e-5f);
                const f32x4 o0 = (t0 * rstd * w0 + b0 + v0 * bo) * g0, o1 = (t1 * rstd * w1 + b1 + v1 * bo) * g1;
                ((GAS u32x4*)(YRW + (size_t)row * D))[64 * j + lane] = pack8(o0, o1); }
        }
    }
}

__device__ __forceinline__ void grid_bar(int wv) { const Frame F = mkframe(wv); xcd_barrier_impl((unsigned*)(wsptr(F) + WS_CTL) + CW_BAR, (volatile LAS unsigned*)(F.lds + MISC_OFF) + 8); }
#define SITE_BEGIN const Frame F = mkframe(wv); unsigned char* ws = wsptr(F); pg8::StaticOrder S;
__device__ __forceinline__ void site_ffn_up(int wv, int f) { SITE_BEGIN
    pg8::Gemm g{(const bf16*)(ws + WS_XB), (const bf16*)(ws + (f ? WS_W2U : WS_W1U)), M, 2 * FF, D, D, D}; S.init(M, 2 * FF, F.G, F.bx);
    EpiSwiGLU E{(bf16*)(ws + WS_H)}; pg8::gemm_phase<EpiSwiGLU>(F.lds, g, S, E, F.wave, F.lane); }
template <int F_, int L_> __device__ __forceinline__ void site_ffn_down(int wv) { SITE_BEGIN
    constexpr int f = F_;
    pg8::Gemm g{(const bf16*)(ws + WS_H), (const bf16*)(ws + (f ? WS_W2D : WS_W1D)), M, D, FF, FF, FF}; S.init(M, D, F.G, F.bx);
    constexpr int prev = L_ * 3 + (F_ ? 1 : -1);
    if constexpr (prev >= 0) { float* Xp = outptr(F); EpiResid<true> E{Xp, Xp, 0.5f, (const float*)(ws + WS_LNS), inptr(F, 34) + (size_t)prev * D, inptr(F, 35) + (size_t)prev * D}; pg8::gemm_phase<EpiResid<true>>(F.lds, g, S, E, F.wave, F.lane); }
    else { EpiResid<false> E{outptr(F), inptr(F, 0), 0.5f, nullptr, nullptr, nullptr}; pg8::gemm_phase<EpiResid<false>>(F.lds, g, S, E, F.wave, F.lane); } }
__device__ __forceinline__ void site_inA(int wv) { SITE_BEGIN
    pg8::Gemm g{(const bf16*)(ws + WS_XB), (const bf16*)(ws + WS_WIN), M, 10496, D, D, D}; S.init(M, 10496, F.G, F.bx);
    EpiInA E{(float*)(ws + WS_LG), (bf16*)(ws + WS_GU), (bf16*)(ws + WS_QB), (bf16*)(ws + WS_K3), (bf16*)(ws + WS_VC)}; pg8::gemm_phase<EpiInA>(F.lds, g, S, E, F.wave, F.lane); }
__device__ __forceinline__ void site_vt(int wv) { SITE_BEGIN
    pg8::Gemm g{(const bf16*)(ws + WS_WIN) + (size_t)10496 * D, (const bf16*)(ws + WS_XB), 1024, M, D, D, D}; S.init(1024, M, F.G, F.bx);
    EpiBf16 E{(bf16*)(ws + WS_VT), M, M, 1024}; pg8::gemm_phase<EpiBf16>(F.lds, g, S, E, F.wave, F.lane); }
__device__ __forceinline__ void site_cmp1(int wv, int l) { SITE_BEGIN
    { pg8::Gemm g{(const bf16*)(ws + WS_K3), (const bf16*)(ws + WS_PK1), 4096, 256, 6144, 3072, 6144}; S.init(4096, 256, F.G, F.bx);
      EpiCmp1 E{(bf16*)(ws + WS_HK), (const float*)(ws + WS_B1) + l * 512}; pg8::gemm_phase<EpiCmp1>(F.lds, g, S, E, F.wave, F.lane); }
    { const int bx2 = (F.bx + F.G - 16) % F.G;
      pg8::Gemm g{(const bf16*)(ws + WS_VC), (const bf16*)(ws + WS_PV1), 4096, 256, 4096, 2048, 4096}; S.init(4096, 256, F.G, bx2);
      EpiCmp1 E{(bf16*)(ws + WS_HV), (const float*)(ws + WS_B1) + l * 512 + 256}; pg8::gemm_phase<EpiCmp1>(F.lds, g, S, E, F.wave, F.lane); } }
__device__ __forceinline__ void site_cmp2(int wv) { SITE_BEGIN
    { pg8::Gemm g{(const bf16*)(ws + WS_HK), (const bf16*)(ws + WS_PK2), 4096, 256, 256, 256, 256}; S.init(4096, 256, F.G, F.bx);
      EpiBf16 E{(bf16*)(ws + WS_KCMP), 192, 192, 4096}; pg8::gemm_phase<EpiBf16>(F.lds, g, S, E, F.wave, F.lane); }
    { const int bx2 = (F.bx + 128) % F.G;
      pg8::Gemm g{(const bf16*)(ws + WS_PV2), (const bf16*)(ws + WS_HV), 256, 4096, 256, 256, 256}; S.init(256, 4096, F.G, bx2);
      EpiBf16 E{(bf16*)(ws + WS_VCMT), 4096, 4096, 128}; pg8::gemm_phase<EpiBf16>(F.lds, g, S, E, F.wave, F.lane); } }
__device__ __forceinline__ void site_rkv(int wv) { SITE_BEGIN
    pg8::Gemm g{(const bf16*)(ws + WS_XB), (const bf16*)(ws + WS_WIN) + (size_t)11520 * D, M, 6144, D, D, D}; S.init(M, 6144, F.G, F.bx);
    EpiBf16 E{(bf16*)(ws + WS_RKV), 6144, 6144, M}; pg8::gemm_phase<EpiBf16>(F.lds, g, S, E, F.wave, F.lane); }
__device__ __forceinline__ void site_lora_wa(int wv, int l) { SITE_BEGIN
    pg8::Gemm g{(const bf16*)(ws + WS_AL), (const bf16*)(ws + WS_LWA), M, 4096, 256, 512, 256}; S.init(M, 4096, F.G, F.bx);
    EpiLoraWA E{(float*)(ws + WS_DEC), (bf16*)(ws + WS_AG), inptr(F, 3) + (size_t)l * D, inptr(F, 5) + (size_t)l * D}; pg8::gemm_phase<EpiLoraWA>(F.lds, g, S, E, F.wave, F.lane); }
__device__ __forceinline__ void site_lora_g(int wv) { SITE_BEGIN
    pg8::Gemm g{(const bf16*)(ws + WS_AL) + 256, (const bf16*)(ws + WS_LG2), M, 2048, 256, 512, 256}; S.init(M, 2048, F.G, F.bx);
    EpiBf16 E{(bf16*)(ws + WS_GG), D, D, M}; pg8::gemm_phase<EpiBf16>(F.lds, g, S, E, F.wave, F.lane); }
__device__ __forceinline__ void site_lora_vl(int wv) { SITE_BEGIN
    const int p = (F.bx * 4) / F.G, nb = F.G / 4;
    pg8::Gemm g{(const bf16*)(ws + WS_VS1) + 512 * p, (const bf16*)(ws + WS_LV1) + 512 * p, M, 256, 512, D, D}; S.init(M, 256, nb, F.bx - p * nb);
    EpiBf16Quarter E{(bf16*)(ws + WS_VL), 256, p}; pg8::gemm_phase<EpiBf16Quarter>(F.lds, g, S, E, F.wave, F.lane); }
__device__ __forceinline__ void site_vmix(int wv) { SITE_BEGIN
    pg8::Gemm g{(const bf16*)(ws + WS_VL), (const bf16*)(ws + WS_LV2), M, 2048, 256, 256, 256}; S.init(M, 2048, F.G, F.bx);
    EpiVmix E{(bf16*)(ws + WS_VS1), (const bf16*)(ws + WS_VS0), inptr(F, 8)}; pg8::gemm_phase<EpiVmix>(F.lds, g, S, E, F.wave, F.lane); }
__device__ __forceinline__ void site_gate(int wv, int t0, int nt, int b0, int nb) { SITE_BEGIN
    if (F.bx < b0 || F.bx >= b0 + nb) return;
    S.init(M, nt * 256, nb, F.bx - b0);
    pg8::Gemm g{(const bf16*)(ws + WS_XB), (const bf16*)(ws + WS_WIN) + (size_t)(17664 + t0 * 256) * D, M, nt * 256, D, D, D};
    EpiSigmoid E{(bf16*)(ws + WS_G) + t0 * 256, 6144}; pg8::gemm_phase<EpiSigmoid>(F.lds, g, S, E, F.wave, F.lane); }
template <int I> __device__ __forceinline__ void site_merge(int wv) { SITE_BEGIN
    pg8::Gemm g{(const bf16*)(ws + (I == 0 ? WS_YRW : I == 1 ? WS_YGM : WS_YNS)), (const bf16*)(ws + WS_WBR + I * SZ_DD), M, D, D, D, D}; S.init(M, D, F.G, F.bx);
    EpiMerge<I> E{(float*)(ws + WS_M32), (bf16*)(ws + WS_MB), (const bf16*)(ws + WS_G) + I * 2048}; pg8::gemm_phase<EpiMerge<I>>(F.lds, g, S, E, F.wave, F.lane); }
__device__ __forceinline__ void site_wo(int wv, int l) { SITE_BEGIN
    pg8::Gemm g{(const bf16*)(ws + WS_MB), (const bf16*)(ws + WS_WO), M, D, D, D, D}; S.init(M, D, F.G, F.bx);
    float* Xp = outptr(F); EpiResid<true> E{Xp, Xp, 1.0f, (const float*)(ws + WS_LNS), inptr(F, 34) + (size_t)(l * 3) * D, inptr(F, 35) + (size_t)(l * 3) * D};
    pg8::gemm_phase<EpiResid<true>>(F.lds, g, S, E, F.wave, F.lane); }

template <int F_, int L_> __device__ __forceinline__ void ffn_body(int wv) {
    constexpr int l = L_;
    site_ffn_up(wv, F_);
    grid_bar(wv);
    site_ffn_down<F_, L_>(wv);
    grid_bar(wv);
    phase_ln(wv, l, F_ ? 2 : 0);
    if (!(F_ == 1 && L_ + 1 < DEPTH)) grid_bar(wv);
}
template <int L_> __device__ __forceinline__ void layer_body(int wv) {
    constexpr int l = L_;
    phase_convert(wv, l);
    phase_convert_small(wv, l);
    grid_bar(wv);
    ffn_body<0, L_>(wv);
    site_inA(wv); site_vt(wv); site_rkv(wv);
    grid_bar(wv);
    phase_gm_stats(wv); site_cmp1(wv, l); site_gate(wv, 0, 10, 32, 224);
    grid_bar(wv);
    phase_gmlp(wv, l); site_cmp2(wv);
    grid_bar(wv);
    phase_nsa_attn(wv); phase_rw_e1(wv, l);
    grid_bar(wv);
    site_lora_wa(wv, l); site_lora_g(wv); if (l > 0) site_lora_vl(wv);
    grid_bar(wv);
    if (l > 0) { site_vmix(wv); grid_bar(wv); }
    phase_scan_chunked(wv, l); site_gate(wv, 10, 14, 128, 128);
    grid_bar(wv);
    phase_rw_e3(wv, l);
    grid_bar(wv);
    site_merge<0>(wv); site_merge<1>(wv); site_merge<2>(wv);
    grid_bar(wv);
    site_wo(wv, l);
    grid_bar(wv);
    phase_ln(wv, l, 1);
    grid_bar(wv);
    ffn_body<1, L_>(wv);
}
__global__ void __launch_bounds__(NTHR, 2) mk_fwd(Args args) {
    extern __shared__ __attribute__((aligned(16))) unsigned char lds_raw[];
    {
        LAS unsigned char* lds = (LAS unsigned char*)lds_raw;
        for (int u = threadIdx.x; u < (LDS_BYTES - LDSCTL_OFF) / 4; u += NTHR) ((LAS unsigned*)(lds + LDSCTL_OFF))[u] = 0u;
        __syncthreads();
        if (threadIdx.x < 38) ((LAS unsigned long long*)(lds + PTAB_OFF))[threadIdx.x] = ((const unsigned long long*)&args)[threadIdx.x];
        __syncthreads();
    }
    const int wv = __builtin_amdgcn_readfirstlane(threadIdx.x >> 6);
    { const Frame F = mkframe(wv); xcd_barrier_post((unsigned*)(wsptr(F) + WS_CTL) + CW_BAR); }
#define GRID_BAR() grid_bar(wv)

    layer_body<0>(wv);
    layer_body<1>(wv);
}

extern "C" void kernel_launch(void* const* d_in, const int* in_sizes, int n_in, void* d_out, int out_size, void* d_ws, size_t ws_size, hipStream_t stream) {
    static int grid = 0;
    if (grid == 0) {
        if (n_in != 36 || out_size != M * D || ws_size < WS_END) { fprintf(stderr, "kernel_launch: unexpected shapes n_in %d out %d ws %zu (need %zu)\n", n_in, out_size, ws_size, (size_t)WS_END); grid = -1; return; }
        int dev = 0, cus = 0, per_cu = 0;
        if (hipGetDevice(&dev) != hipSuccess || hipDeviceGetAttribute(&cus, hipDeviceAttributeMultiprocessorCount, dev) != hipSuccess) { grid = -1; return; }
        if (hipFuncSetAttribute((const void*)mk_fwd, hipFuncAttributeMaxDynamicSharedMemorySize, LDS_BYTES) != hipSuccess) { fprintf(stderr, "kernel_launch: hipFuncSetAttribute failed\n"); grid = -1; return; }
        if (hipOccupancyMaxActiveBlocksPerMultiprocessor(&per_cu, (const void*)mk_fwd, NTHR, LDS_BYTES) != hipSuccess || per_cu < 1) fprintf(stderr, "kernel_launch: occupancy query says %d\n", per_cu);
        (void)hipGetLastError();
        grid = cus;
    }
    if (grid < 0) return;
    if (hipMemsetAsync((char*)d_ws + WS_CTL, 0, CTL_ZERO_BYTES, stream) != hipSuccess) return;
    Args a{};
    for (int i = 0; i < 36; ++i) a.in[i] = (const float*)d_in[i];
    a.out = (float*)d_out; a.ws = (unsigned char*)d_ws;
    hipLaunchKernelGGL(mk_fwd, dim3(grid), dim3(NTHR), LDS_BYTES, stream, a);
}
```

```cpp
#include <hip/hip_runtime.h>
#include <cstdio>
#include <cstdint>

#define LAS __attribute__((address_space(3)))
#define GAS __attribute__((address_space(1)))
typedef unsigned short bf16;
typedef short bf16x8 __attribute__((ext_vector_type(8)));
typedef float f32x4 __attribute__((ext_vector_type(4)));
typedef float f32x2 __attribute__((ext_vector_type(2)));
typedef unsigned u32x4 __attribute__((ext_vector_type(4)));
typedef unsigned u32x2 __attribute__((ext_vector_type(2)));
typedef GAS unsigned gu32;

constexpr int NB = 4, T = 4096, D = 2048, M = NB * T, FF = 5632, DEPTH = 2;
constexpr int C_IN = 23792;
constexpr float ALPHA = 1.41421356237f;
constexpr float LN_EPS = 1e-5f;
constexpr int NWAVES = 8, NTHR = 512;

constexpr int RING_BYTES = 131072;
constexpr int LDSCTL_OFF = RING_BYTES, MISC_OFF = LDSCTL_OFF + 320;
constexpr int LDS_BYTES = 147456;

constexpr size_t MiB = 1u << 20;
constexpr size_t alup(size_t x) { return (x + 4095) & ~(size_t)4095; }
constexpr size_t WS_CTL = 0, CTL_ZERO_BYTES = 1 * MiB;
constexpr size_t SZ_W1U = (size_t)2 * FF * D * 2, SZ_W1D = (size_t)D * FF * 2, SZ_WIN = (size_t)23808 * D * 2, SZ_DD = (size_t)D * D * 2;
constexpr size_t WS_W1U = 1 * MiB;
constexpr size_t WS_W1D = WS_W1U + SZ_W1U;
constexpr size_t WS_W2U = WS_W1D + SZ_W1D;
constexpr size_t WS_W2D = WS_W2U + SZ_W1U;
constexpr size_t WS_WIN = WS_W2D + SZ_W1D;
constexpr size_t WS_WBR = WS_WIN + SZ_WIN;
constexpr size_t WS_WO  = WS_WBR + 3 * SZ_DD;
constexpr size_t WS_LWA = WS_WO + SZ_DD;
constexpr size_t WS_LG2 = WS_LWA + 4096 * 256 * 2;
constexpr size_t WS_LV1 = WS_LG2 + 2048 * 256 * 2;
constexpr size_t WS_LV2 = WS_LV1 + 256 * 2048 * 2;
constexpr size_t WS_PK1 = WS_LV2 + 2048 * 256 * 2;
constexpr size_t WS_PK2 = WS_PK1 + 256 * 6144 * 2;
constexpr size_t WS_PV1 = WS_PK2 + 256 * 256 * 2;
constexpr size_t WS_PV2 = WS_PV1 + 256 * 4096 * 2;
constexpr size_t WS_WEND = WS_PV2 + 256 * 256 * 2;
constexpr size_t SZ_MD2 = (size_t)M * D * 2, SZ_MD4 = (size_t)M * D * 4;
constexpr size_t WS_XB  = alup(WS_WEND);
constexpr size_t WS_VS0 = WS_XB + SZ_MD2;
constexpr size_t WS_YRW = WS_VS0 + SZ_MD2;
constexpr size_t WS_YGM = WS_YRW + SZ_MD2;
constexpr size_t WS_YNS = WS_YGM + SZ_MD2;
constexpr size_t WS_ARENA = WS_YNS + SZ_MD2;
constexpr size_t WS_H   = WS_ARENA;
constexpr size_t WS_LG  = WS_ARENA;
constexpr size_t WS_RKV = WS_LG + (size_t)M * 512 * 4;
constexpr size_t WS_R2  = WS_RKV + (size_t)M * 6144 * 2;
constexpr size_t WS_GU   = WS_R2;
constexpr size_t WS_QB   = WS_GU + (size_t)M * 4096 * 2;
constexpr size_t SZ_K1   = (size_t)16 * T * 192 * 2;
constexpr size_t WS_K3   = WS_QB + (size_t)M * 3072 * 2;
constexpr size_t WS_VC   = WS_K3 + 3 * SZ_K1;
constexpr size_t WS_VT   = WS_VC + (size_t)16 * T * 128 * 2 + 65536;
constexpr size_t WS_HK   = WS_VT + (size_t)1024 * M * 2;
constexpr size_t WS_HV   = WS_HK + 4096 * 256 * 2;
constexpr size_t WS_KCMP = WS_HV + 4096 * 256 * 2;
constexpr size_t WS_VCMT = WS_KCMP + 4096 * 192 * 2;
constexpr size_t WS_GST  = WS_VCMT + 128 * 4096 * 2;
constexpr size_t WS_YN   = WS_GST + (size_t)M * 8;
constexpr size_t WS_R2A_END = WS_YN + SZ_MD4;
constexpr size_t WS_AL   = WS_R2;
constexpr size_t WS_VS1  = WS_AL + (size_t)M * 512 * 2;
constexpr size_t WS_VL   = WS_VS1 + SZ_MD2;
constexpr size_t WS_DEC  = WS_VL + (size_t)M * 256 * 2;
constexpr size_t WS_AG   = WS_DEC + SZ_MD4;
constexpr size_t WS_GG   = WS_AG + SZ_MD2;
constexpr size_t WS_YR   = WS_GG + SZ_MD2;
constexpr size_t WS_BON  = WS_YR + SZ_MD4;
static_assert(WS_VL + (size_t)M * 256 * 2 <= WS_QB, "A_L / VS1 / VL must stay inside GU (dead during the attention phase)");
constexpr size_t WS_R2B_END = WS_BON + (size_t)M * 32 * 4;
constexpr size_t WS_G    = WS_R2B_END;
constexpr size_t WS_M32  = WS_R2;
constexpr size_t WS_MB   = WS_R2;
constexpr size_t WS_R2C_END = WS_G + (size_t)M * 6144 * 2;
constexpr size_t cmax(size_t a, size_t b) { return a > b ? a : b; }
constexpr size_t WS_END = cmax(cmax(WS_R2A_END, WS_R2B_END), cmax(WS_R2C_END, WS_H + (size_t)M * FF * 2));
constexpr size_t WS_LNS = 640 * 1024;
constexpr size_t WS_B1 = 512 * 1024;

constexpr int CW_TMO = 0, CW_BAR = 4096;

__device__ __forceinline__ unsigned f2bf(float f) { unsigned u = __builtin_bit_cast(unsigned, f); return (u + 0x7fffu + ((u >> 16) & 1u)) >> 16; }
typedef __bf16 hwbf2 __attribute__((ext_vector_type(2)));
__device__ __forceinline__ unsigned pk2h(float lo, float hi) { const f32x2 v = {lo, hi}; const hwbf2 b = __builtin_convertvector(v, hwbf2); return __builtin_bit_cast(unsigned, b); }
__device__ __forceinline__ unsigned pk2(float lo, float hi) { return pk2h(lo, hi); }
__device__ __forceinline__ float bf2f(unsigned short b) { return __builtin_bit_cast(float, ((unsigned)b) << 16); }
__device__ __forceinline__ float bflo(unsigned w) { return __builtin_bit_cast(float, w << 16); }
__device__ __forceinline__ float bfhi(unsigned w) { return __builtin_bit_cast(float, w & 0xffff0000u); }
#define LDS_WAIT() asm volatile("s_waitcnt lgkmcnt(0)" ::: "memory")
#define VM_WAIT() asm volatile("s_waitcnt vmcnt(0)" ::: "memory")

__device__ __forceinline__ int opaque_tid() { int t = threadIdx.x; asm volatile("" : "+v"(t)); return t; }
__device__ __forceinline__ int opaque_s(int x) { asm volatile("" : "+s"(x)); return x; }
namespace pg8 {
constexpr int BM = 256, BK = 64, HALF = 128, HTB = HALF * BK * 2, STAGE_BYTES = 8 * HTB, NXCD = 8, WGM = 4;
__host__ __device__ __forceinline__ int lds_byte(int r, int c) { const int st = (r >> 4) * 2 + (c >> 5), rr = r & 15, cc = c & 31, ob = rr * 64 + cc * 2; return st * 1024 + (ob ^ (((ob >> 9) & 1) << 5)); }
__host__ __device__ __forceinline__ void stage_rc(int b, int& R, int& C) { const int st = b / 1024, sb = b % 1024, swz = sb ^ (((sb >> 9) & 1) << 5); R = (st >> 1) * 16 + swz / 64; C = (st & 1) * 32 + (swz % 64) / 2; }
__host__ __device__ __forceinline__ int perm32(int rho) { const int n = rho >> 4, i = rho & 15; return 8 * (i >> 2) + 4 * n + (i & 3); }
struct Unit { int pm, pn; };
struct Gemm { const bf16* A; const bf16* Bt; int M, N, K, lda, ldb; };
struct StaticOrder {
    int nM, nN, nwg, G, c;
    __host__ __device__ void init(int M_, int N_, int G_, int c_) { nM = M_ / BM; nN = N_ / BM; nwg = nM * nN; G = G_; c = c_; }
    __host__ __device__ bool next(int i, Unit& u) const {
        const long L = (long)i * G + c; if (L >= nwg) return false;
        int wgid = (int)L; { const int q = nwg / NXCD, r = nwg % NXCD, xcd = wgid % NXCD, off = wgid / NXCD; wgid = (xcd < r ? xcd * (q + 1) : r * (q + 1) + (xcd - r) * q) + off; }
        const int nig = WGM * nN, gid = wgid / nig, fm = gid * WGM, gsz = (nM - fm) < WGM ? (nM - fm) : WGM;
        u.pm = fm + ((wgid % nig) % gsz); u.pn = (wgid % nig) / gsz; return true;
    }
};
template <class Epi>
__device__ __forceinline__ void gemm_phase(LAS unsigned char* lds, const Gemm g, const StaticOrder& S, const Epi& E, int wid, int lane_in) {
    const int lane = lane_in, tid = wid * 64 + lane, wr = wid >> 2, wc = wid & 3, fr = lane & 15, fq = lane >> 4;
    const int K = g.K, nt = K / BK;
    unsigned voffA[2], voffB[2];
#pragma unroll
    for (int i = 0; i < 2; ++i) { int R, C; stage_rc(tid * 16 + i * 8192, R, C); const int Rb = (R & ~31) + perm32(R & 31);
        voffA[i] = (unsigned)(R * g.lda + C) * 2u; voffB[i] = (unsigned)(Rb * g.ldb + C) * 2u; }
    const size_t kstep = (size_t)(BK * 2);
    const size_t hstepA = (size_t)HALF * g.lda * 2, hstepB = (size_t)HALF * g.ldb * 2;
    const size_t tstepA = 2 * hstepA, tstepB = 2 * hstepB;
    const unsigned ldsw = (unsigned)wid * 1024u;
    const int aoff = lds_byte(wr * 64 + fr, fq * 8), boff = lds_byte(wc * 32 + fr, fq * 8);
#define PG8_SA(b, h) (((b) * 2 + (h)) * HTB)
#define PG8_SB(b, h) ((4 + (b) * 2 + (h)) * HTB)
#define PG8_STAGE(bufoff, gbase, voff) do { _Pragma("unroll") for (int _i = 0; _i < 2; ++_i) \
        __builtin_amdgcn_global_load_lds((const unsigned*)((const char*)(gbase) + (voff)[_i]), (LAS unsigned*)(lds + (bufoff) + ldsw + _i * 8192), 16, 0, 0); } while (0)
#define PG8_LDA(dst, b, h) do { _Pragma("unroll") for (int m = 0; m < 4; ++m) _Pragma("unroll") for (int k = 0; k < 2; ++k) dst[m][k] = *(const LAS bf16x8*)(lds + PG8_SA(b, h) + aoff + m * 2048 + k * 1024); } while (0)
#define PG8_LDB(dst, b, h) do { _Pragma("unroll") for (int n = 0; n < 2; ++n) _Pragma("unroll") for (int k = 0; k < 2; ++k) dst[n][k] = *(const LAS bf16x8*)(lds + PG8_SB(b, h) + boff + n * 2048 + k * 1024); } while (0)
#define PG8_MMA(ai, bj, At, Bt) do { __builtin_amdgcn_s_setprio(1); _Pragma("unroll") for (int m = 0; m < 4; ++m) _Pragma("unroll") for (int n = 0; n < 2; ++n) _Pragma("unroll") for (int k = 0; k < 2; ++k) \
        acc[ai][bj][m][n] = __builtin_amdgcn_mfma_f32_16x16x32_bf16(Bt[n][k], At[m][k], acc[ai][bj][m][n], 0, 0, 0); __builtin_amdgcn_s_setprio(0); } while (0)
#define PG8_WAIT_V(n) asm volatile("s_waitcnt vmcnt(" #n ")" ::: "memory")
#define PG8_WAIT_L(n) asm volatile("s_waitcnt lgkmcnt(" #n ")" ::: "memory")
#define PG8_BAR __builtin_amdgcn_s_barrier()
#define PG8_SCHED __builtin_amdgcn_sched_barrier(0)
    Unit cur, nxt; int ui = 0;
    if (!S.next(0, cur)) return;
    f32x4 acc[2][2][4][2];
#pragma unroll
    for (int a = 0; a < 2; ++a)
#pragma unroll
        for (int b = 0; b < 2; ++b)
#pragma unroll
            for (int m = 0; m < 4; ++m)
#pragma unroll
                for (int n = 0; n < 2; ++n) acc[a][b][m][n] = (f32x4){0.f, 0.f, 0.f, 0.f};
    bf16x8 At[4][2], B0[2][2], B1[2][2];
    const char* cA = (const char*)g.A + (size_t)cur.pm * tstepA; const char* cB = (const char*)g.Bt + (size_t)cur.pn * tstepB;
    PG8_STAGE(PG8_SB(0, 0), cB, voffB); PG8_STAGE(PG8_SB(0, 1), cB + hstepB, voffB); PG8_STAGE(PG8_SA(0, 0), cA, voffA); PG8_STAGE(PG8_SA(0, 1), cA + hstepA, voffA);
    if (wr == 1) PG8_BAR;
    PG8_WAIT_V(2); PG8_BAR;
    PG8_STAGE(PG8_SB(1, 0), cB + kstep, voffB); PG8_STAGE(PG8_SA(1, 0), cA + kstep, voffA); PG8_STAGE(PG8_SB(1, 1), cB + hstepB + kstep, voffB);
    PG8_WAIT_V(6); PG8_BAR;
    for (;;) {
        const bool has_next = S.next(ui + 1, nxt);
        const char* nA = has_next ? (const char*)g.A + (size_t)nxt.pm * tstepA : cA; const char* nB = has_next ? (const char*)g.Bt + (size_t)nxt.pn * tstepB : cB;
        for (int t = 0; t < nt; t += 2) {
            const bool last = (t == nt - 2);
            const char* a1 = cA + (size_t)(t + 1) * kstep;
            const char* a2 = last ? nA : cA + (size_t)(t + 2) * kstep; const char* b2 = last ? nB : cB + (size_t)(t + 2) * kstep;
            const char* a3 = a2 + kstep; const char* b3 = b2 + kstep;
            PG8_LDB(B0, 0, 0); PG8_LDB(B1, 0, 1); PG8_SCHED; PG8_LDA(At, 0, 0); PG8_STAGE(PG8_SA(1, 1), a1 + hstepA, voffA);
            PG8_WAIT_V(8); PG8_WAIT_L(0); PG8_BAR; PG8_MMA(0, 0, At, B0); PG8_MMA(0, 1, At, B1); PG8_BAR; PG8_SCHED;
            PG8_LDA(At, 0, 1); PG8_STAGE(PG8_SB(0, 0), b2, voffB); PG8_STAGE(PG8_SB(0, 1), b2 + hstepB, voffB); PG8_STAGE(PG8_SA(0, 0), a2, voffA);
            PG8_WAIT_V(8); PG8_WAIT_L(0); PG8_BAR; PG8_MMA(1, 0, At, B0); PG8_MMA(1, 1, At, B1); PG8_BAR; PG8_SCHED;
            PG8_LDB(B0, 1, 0); PG8_LDB(B1, 1, 1); PG8_SCHED; PG8_LDA(At, 1, 0); PG8_STAGE(PG8_SA(0, 1), a2 + hstepA, voffA);
            PG8_WAIT_V(8); PG8_WAIT_L(0); PG8_BAR; PG8_MMA(0, 0, At, B0); PG8_MMA(0, 1, At, B1); PG8_BAR; PG8_SCHED;
            PG8_LDA(At, 1, 1); PG8_STAGE(PG8_SB(1, 0), b3, voffB); PG8_STAGE(PG8_SB(1, 1), b3 + hstepB, voffB); PG8_STAGE(PG8_SA(1, 0), a3, voffA);
            PG8_WAIT_V(8); PG8_WAIT_L(0); PG8_BAR; PG8_MMA(1, 0, At, B0); PG8_MMA(1, 1, At, B1); PG8_BAR; PG8_SCHED;
        }
        if (wr == 0) PG8_BAR;
        E(acc, cur, wr, wc, fr, fq);
        if (!has_next) break;
#pragma unroll
        for (int a = 0; a < 2; ++a)
#pragma unroll
            for (int b = 0; b < 2; ++b)
#pragma unroll
                for (int m = 0; m < 4; ++m)
#pragma unroll
                    for (int n = 0; n < 2; ++n) acc[a][b][m][n] = (f32x4){0.f, 0.f, 0.f, 0.f};
        cur = nxt; cA = nA; cB = nB; ++ui;
        if (wr == 1) PG8_BAR;
    }
    PG8_WAIT_V(0);
    PG8_BAR;
#undef PG8_SA
#undef PG8_SB
#undef PG8_STAGE
#undef PG8_LDA
#undef PG8_LDB
#undef PG8_MMA
#undef PG8_WAIT_V
#undef PG8_WAIT_L
#undef PG8_BAR
#undef PG8_SCHED
}
}

#define XB_TMO      128
#define XB_XCNT(j)  (256  + 64 * (j))
#define XB_XSUB(j)  (1280 + 64 * (j))
#define XB_XGEN(j)  (2304 + 64 * (j))
#define XB_TOP      3328
#define XB_TOPGEN   3392
#define XCD_BAR_WORDS 3456
#define XB_SPIN_CAP (1u << 22)
__device__ __forceinline__ unsigned xb_ld(unsigned* p)              { return __hip_atomic_load(p, __ATOMIC_RELAXED, __HIP_MEMORY_SCOPE_AGENT); }
__device__ __forceinline__ unsigned xb_add(unsigned* p, unsigned v) { return __hip_atomic_fetch_add(p, v, __ATOMIC_RELAXED, __HIP_MEMORY_SCOPE_AGENT); }
__device__ __forceinline__ unsigned xb_xcc_id() { return (unsigned)__builtin_amdgcn_s_getreg((3 << 11) | 20) & 0xFu; }
#define XB_SPIN(cond, bar) do { unsigned _sp = 0; while (cond) { __builtin_amdgcn_s_sleep(1); \
    if ((++_sp & 255u) == 0u) { if (xb_ld(&(bar)[XB_TMO])) break; if (_sp > XB_SPIN_CAP) { atomicAdd(&(bar)[XB_TMO], 1u); break; } } } } while (0)
__device__ __forceinline__ void xcd_barrier_post(unsigned* bar) {
    if (threadIdx.x == 0) (void)xb_add(&bar[XB_XCNT(xb_xcc_id())], 1u);
}
__device__ __forceinline__ void xcd_barrier_complete(unsigned* bar, unsigned x, unsigned& nloc, unsigned& nx) {
    const unsigned G = gridDim.x * gridDim.y * gridDim.z;
    unsigned sum, cnt, sp = 0u;
    for (;;) {
        sum = 0u; cnt = 0u;
#pragma unroll 1
        for (unsigned j = 0; j < 16; ++j) { const unsigned c = xb_ld(&bar[XB_XCNT(j)]); sum += c; cnt += (c > 0u) ? 1u : 0u; }
        if (sum == G) break;
        __builtin_amdgcn_s_sleep(1);
        if ((++sp & 255u) == 0u) { if (xb_ld(&bar[XB_TMO])) break; if (sp > XB_SPIN_CAP) { atomicAdd(&bar[XB_TMO], 1u); break; } }
    }
    const unsigned mine = xb_ld(&bar[XB_XCNT(x)]);
    nloc = mine > 0u ? mine : 1u; nx = cnt > 0u ? cnt : 1u;
}
__device__ __forceinline__ void xcd_barrier_impl(unsigned* bar_in, volatile LAS unsigned* st) {
    asm volatile("s_waitcnt vmcnt(0)" ::: "memory");
    __syncthreads();
    if (threadIdx.x == 0) {
        unsigned* bar = bar_in; asm volatile("" : "+v"(bar));
        const unsigned x = xb_xcc_id();
        __builtin_amdgcn_s_waitcnt(0);
        unsigned nloc = st[0], nx = st[1];
        if (nloc == 0u) { xcd_barrier_complete(bar, x, nloc, nx); st[0] = nloc; st[1] = nx; }
        const unsigned old = xb_add(&bar[XB_XSUB(x)], 1u);
        const unsigned gen = old / nloc;
        if (old + 1u == (gen + 1u) * nloc) {
            __builtin_amdgcn_fence(__ATOMIC_RELEASE, "agent");
            asm volatile("s_waitcnt vmcnt(0)" ::: "memory");
            const unsigned og = xb_add(&bar[XB_TOP], 1u);
            const unsigned tg = og / nx;
            if (og + 1u == (tg + 1u) * nx) xb_add(&bar[XB_TOPGEN], 1u);
            else XB_SPIN(xb_ld(&bar[XB_TOPGEN]) == tg, bar);
            __builtin_amdgcn_fence(__ATOMIC_ACQUIRE, "agent");
            xb_add(&bar[XB_XGEN(x)], 1u);
            asm volatile("s_waitcnt vmcnt(0)" ::: "memory");
        } else {
            XB_SPIN(xb_ld(&bar[XB_XGEN(x)]) == gen, bar);
            __builtin_amdgcn_fence(__ATOMIC_ACQUIRE, "agent");
            asm volatile("s_waitcnt vmcnt(0)" ::: "memory");
        }
    }
    __syncthreads();
}

template <int CTRL> __device__ __forceinline__ float dpp(float x) { return __builtin_bit_cast(float, __builtin_amdgcn_mov_dpp(__builtin_bit_cast(int, x), CTRL, 0xf, 0xf, true)); }
__device__ __forceinline__ float xlane(float v, int src_lane) { return __builtin_bit_cast(float, __builtin_amdgcn_ds_bpermute(src_lane << 2, __builtin_bit_cast(int, v))); }
__device__ __forceinline__ float wave_sum(float v, int lane) {
    v += dpp<0xB1>(v); v += dpp<0x4E>(v); v += dpp<0x141>(v); v += dpp<0x140>(v);
    v += xlane(v, lane ^ 16); v += xlane(v, lane ^ 32);
    return v;
}
__device__ __forceinline__ float sigmoidf_(float x) { return __builtin_amdgcn_rcpf(1.0f + __expf(-x)); }
__device__ __forceinline__ float siluf_(float x) { return x * __builtin_amdgcn_rcpf(1.0f + __expf(-x)); }
__device__ __forceinline__ float gelu_tanh(float x) { const float u = 1.5957691216f * (x + 0.044715f * x * x * x); return x * __builtin_amdgcn_rcpf(1.0f + __expf(-u)); }

struct Args { const float* in[36]; float* out; unsigned char* ws; };
struct Frame { LAS unsigned char* lds; int tid, lane, wave, bx, G, vcu; };
__device__ __forceinline__ Frame mkframe(int wv) {
    Frame F; unsigned z; asm volatile("s_mov_b32 %0, 0" : "=s"(z)); F.lds = (LAS unsigned char*)(uintptr_t)z;
    int l_; asm volatile("v_mbcnt_lo_u32_b32 %0, -1, 0\n\tv_mbcnt_hi_u32_b32 %0, -1, %0" : "=v"(l_)); asm volatile("" : "+s"(wv)); F.lane = l_; F.wave = wv; F.tid = wv * 64 + l_;
    int bx = blockIdx.x; asm volatile("" : "+s"(bx)); F.bx = bx; int G = gridDim.x; asm volatile("" : "+s"(G)); F.G = G;
    F.vcu = (G % 8 == 0) ? (bx % 8) * (G / 8) + bx / 8 : bx;
    return F;
}
constexpr int PTAB_OFF = LDSCTL_OFF + 1024;
__device__ __forceinline__ unsigned long long ptab_rd(const Frame& F, int i) {
    const unsigned long long v = ((volatile LAS unsigned long long*)(F.lds + PTAB_OFF))[i];
    const unsigned lo = __builtin_amdgcn_readfirstlane((unsigned)v), hi = __builtin_amdgcn_readfirstlane((unsigned)(v >> 32));
    return ((unsigned long long)hi << 32) | lo;
}
__device__ __forceinline__ const float* inptr(const Frame& F, int i) { return (const float*)ptab_rd(F, i); }
__device__ __forceinline__ float* outptr(const Frame& F) { return (float*)ptab_rd(F, 36); }
__device__ __forceinline__ unsigned char* wsptr(const Frame& F) { return (unsigned char*)ptab_rd(F, 37); }

__device__ __forceinline__ void transpose_item64(const float* W, int ld, int srccol, bf16* WT, int K, int d0, int k0, LAS unsigned* scr, int lane) {
    const int g = lane >> 4, fr = lane & 15;
    f32x4 v[16];
#pragma unroll
    for (int p = 0; p < 8; ++p)
#pragma unroll
        for (int e = 0; e < 2; ++e) { const int k = 8 * p + 2 * g + e; v[2 * p + e] = srccol >= 0 ? __builtin_nontemporal_load((const GAS f32x4*)(W + (size_t)(k0 + k) * ld + srccol)) : (f32x4){0.f, 0.f, 0.f, 0.f}; }
#pragma unroll
    for (int p = 0; p < 8; ++p) { const int kp = 4 * p + g;
#pragma unroll
        for (int i = 0; i < 4; ++i) scr[kp * 65 + 4 * fr + i] = pk2(v[2 * p][i], v[2 * p + 1][i]); }
    LDS_WAIT(); asm volatile("" ::: "memory");
    const int c = lane & 7;
#pragma unroll
    for (int j = 0; j < 8; ++j) { const int n = (lane >> 3) + 8 * j;
        u32x4 o; o.x = scr[(4 * c + 0) * 65 + n]; o.y = scr[(4 * c + 1) * 65 + n]; o.z = scr[(4 * c + 2) * 65 + n]; o.w = scr[(4 * c + 3) * 65 + n];
        *(GAS u32x4*)(WT + (size_t)(d0 + n) * K + k0 + 8 * c) = o; }
    LDS_WAIT(); asm volatile("" ::: "memory");
}
__device__ __forceinline__ int win_map(int d) {
    if (d < 96) return 6144 + d;
    if (d < 192) return 6240 + (d - 96);
    if (d < 448) return 6336 + (d - 192);
    if (d < 496) return 17600 + (d - 448);
    if (d < 512) return -1;
    if (d < 4608) return 6592 + (d - 512);
    if (d < 7680) return 10688 + (d - 4608);
    if (d < 9984) { const int e = d - 7680, ty = e / 768; return 13760 + ty * 1280 + (e - ty * 768); }
    if (d < 10496) return 14528 + (d - 9984);
    if (d < 11008) return 15808 + (d - 10496);
    if (d < 11520) return 17088 + (d - 11008);
    if (d < 17664) return d - 11520;
    return 17648 + (d - 17664);
}

__device__ __forceinline__ void phase_convert(int wv, int l) {
    const Frame F = mkframe(wv); unsigned char* ws = wsptr(F);
    const int tid = F.tid, lane = F.lane, wave = F.wave;
    LAS unsigned* scr = (LAS unsigned*)(F.lds + wave * 8448);
    const int gw = F.vcu * NWAVES + wave, NGW = F.G * NWAVES;
    constexpr int I_UP = (2 * FF / 64) * (D / 64), I_DN = (D / 64) * (FF / 64), I_IN = (23808 / 64) * (D / 64), I_DD = (D / 64) * (D / 64);
    constexpr int NIT = 2 * I_UP + 2 * I_DN + I_IN + 4 * I_DD;
    const int n4 = 4 * (lane & 15);
    for (int it = gw; it < NIT; it += NGW) {
        int r = it;
        if (r < 2 * I_UP) { const int which = r / I_UP; r -= which * I_UP; const int nb = r / (D / 64), kb = r % (D / 64), d0 = nb * 64;
            const int pn = d0 >> 8, half = (d0 >> 7) & 1, i0 = d0 & 127;
            const float* src = inptr(F, (which ? 31 : 28) + half) + (size_t)l * D * FF;
            transpose_item64(src, FF, 128 * pn + i0 + n4, (bf16*)(ws + (which ? WS_W2U : WS_W1U)), D, d0, kb * 64, scr, lane); continue; }
        r -= 2 * I_UP;
        if (r < 2 * I_DN) { const int which = r / I_DN; r -= which * I_DN; const int nb = r / (FF / 64), kb = r % (FF / 64), d0 = nb * 64;
            const float* src = inptr(F, which ? 33 : 30) + (size_t)l * FF * D;
            transpose_item64(src, D, d0 + n4, (bf16*)(ws + (which ? WS_W2D : WS_W1D)), FF, d0, kb * 64, scr, lane); continue; }
        r -= 2 * I_DN;
        if (r < I_IN) { const int nb = r / (D / 64), kb = r % (D / 64), d0 = nb * 64;
            const float* src = inptr(F, 1) + (size_t)l * D * C_IN;
            transpose_item64(src, C_IN, win_map(d0 + n4), (bf16*)(ws + WS_WIN), D, d0, kb * 64, scr, lane); continue; }
        r -= I_IN;
        { const int which = r / I_DD; r -= which * I_DD; const int nb = r / (D / 64), kb = r % (D / 64), d0 = nb * 64;
            const float* src = which < 3 ? inptr(F, 26) + ((size_t)l * 3 + which) * D * D : inptr(F, 27) + (size_t)l * D * D;
            transpose_item64(src, D, d0 + n4, (bf16*)(ws + (which < 3 ? WS_WBR + which * SZ_DD : WS_WO)), D, d0, kb * 64, scr, lane); }
    }
    if (l == 0) {
        const float* x = inptr(F, 0); bf16* XB = (bf16*)(ws + WS_XB);
        const size_t n4 = (size_t)M * D / 4, stride = (size_t)F.G * NTHR;
        for (size_t i = (size_t)F.bx * NTHR + tid; i < n4; i += 4 * stride) {
            f32x4 v[4];
#pragma unroll
            for (int q = 0; q < 4; ++q) v[q] = ((const GAS f32x4*)x)[i + q * stride < n4 ? i + q * stride : i];
#pragma unroll
            for (int q = 0; q < 4; ++q) if (i + q * stride < n4) { u32x2 o; o.x = pk2(v[q].x, v[q].y); o.y = pk2(v[q].z, v[q].w); ((GAS u32x2*)XB)[i + q * stride] = o; } }
    }
}

__device__ __forceinline__ void phase_ln(int wv, int l, int which) {
    const Frame F = mkframe(wv); const int lane = F.lane, wave = F.wave;
    float* X = outptr(F); bf16* XB = (bf16*)(wsptr(F) + WS_XB); const float* g = inptr(F, 34) + ((size_t)l * 3 + which) * D; const float* b = inptr(F, 35) + ((size_t)l * 3 + which) * D;
    float* stats = (float*)(wsptr(F) + WS_LNS); const bool final = (l == DEPTH - 1 && which == 2);
    const int gw = F.vcu * NWAVES + wave, NGW = F.G * NWAVES;
    f32x4 nx[8];
    { const GAS f32x4* xr = (const GAS f32x4*)(X + (size_t)min(gw, M - 1) * D) + lane;
#pragma unroll
      for (int j = 0; j < 8; ++j) nx[j] = __builtin_nontemporal_load(xr + 64 * j); }
    for (int row = gw; row < M; row += NGW) {
        GAS f32x4* xr = (GAS f32x4*)(X + (size_t)row * D) + lane;
        f32x4 v[8]; float s = 0.f;
#pragma unroll
        for (int j = 0; j < 8; ++j) { v[j] = nx[j]; s += (v[j].x + v[j].y) + (v[j].z + v[j].w); }
        { const GAS f32x4* xn = (const GAS f32x4*)(X + (size_t)min(row + NGW, M - 1) * D) + lane;
#pragma unroll
          for (int j = 0; j < 8; ++j) nx[j] = __builtin_nontemporal_load(xn + 64 * j); }
        const float mean = wave_sum(s, lane) * (1.f / D); float s2 = 0.f;
#pragma unroll
        for (int j = 0; j < 8; ++j) { v[j] = v[j] - mean; s2 += (v[j].x * v[j].x + v[j].y * v[j].y) + (v[j].z * v[j].z + v[j].w * v[j].w); }
        const float rstd = 1.f / sqrtf(wave_sum(s2, lane) * (1.f / D) + LN_EPS);
        GAS u32x2* o8 = (GAS u32x2*)(XB + (size_t)row * D) + lane;
#pragma unroll
        for (int j = 0; j < 8; ++j) { const f32x4 gg = ((const GAS f32x4*)g)[lane + 64 * j], bb = ((const GAS f32x4*)b)[lane + 64 * j];
            const f32x4 y = v[j] * rstd * gg + bb; if (final) xr[64 * j] = y; else { u32x2 o; o.x = pk2(y.x, y.y); o.y = pk2(y.z, y.w); o8[64 * j] = o; } }
        if (lane == 0) *(GAS f32x2*)(stats + 2 * row) = (f32x2){mean, rstd};
    }
}

__device__ __forceinline__ int fresh_lane() { int l; asm volatile("v_mbcnt_lo_u32_b32 %0, -1, 0\n\tv_mbcnt_hi_u32_b32 %0, -1, %0" : "=v"(l)); return l; }

using pg8::Unit;
struct EpiSwiGLU {
    bf16* H;
    __device__ __forceinline__ void operator()(const f32x4 (&acc)[2][2][4][2], const Unit& u, int wr, int wc, int fr_, int fq_) const { const int l__ = fresh_lane(), fr = l__ & 15, fq = l__ >> 4; (void)fr_; (void)fq_;
        const int col = u.pn * 128 + wc * 32 + 8 * fq;
#pragma unroll
        for (int ai = 0; ai < 2; ++ai)
#pragma unroll
            for (int m = 0; m < 4; ++m) { const int row = u.pm * 256 + ai * 128 + wr * 64 + m * 16 + fr;
                const f32x4 g0 = acc[ai][0][m][0], g1 = acc[ai][0][m][1], u0 = acc[ai][1][m][0], u1 = acc[ai][1][m][1];
                u32x4 w; w.x = pk2h(siluf_(g0[0]) * u0[0], siluf_(g0[1]) * u0[1]); w.y = pk2h(siluf_(g0[2]) * u0[2], siluf_(g0[3]) * u0[3]);
                w.z = pk2h(siluf_(g1[0]) * u1[0], siluf_(g1[1]) * u1[1]); w.w = pk2h(siluf_(g1[2]) * u1[2], siluf_(g1[3]) * u1[3]);
                *(GAS u32x4*)(H + (size_t)row * FF + col) = w; }
    }
};
template <bool LN> struct EpiResid {
    float* X; const float* Xr; float s; const float* stats; const float* lng; const float* lnb;
    __device__ __forceinline__ void operator()(const f32x4 (&acc)[2][2][4][2], const Unit& u, int wr, int wc, int fr_, int fq_) const { const int l__ = fresh_lane(), fr = l__ & 15, fq = l__ >> 4; (void)fr_; (void)fq_;
#pragma unroll
        for (int bj = 0; bj < 2; ++bj) { const int col = u.pn * 256 + bj * 128 + wc * 32 + 8 * fq;
            f32x4 g0 = (f32x4){1.f, 1.f, 1.f, 1.f}, g1 = g0, b0 = (f32x4){0.f, 0.f, 0.f, 0.f}, b1 = b0;
            if (LN) { g0 = *(const GAS f32x4*)(lng + col); g1 = *(const GAS f32x4*)(lng + col + 4); b0 = *(const GAS f32x4*)(lnb + col); b1 = *(const GAS f32x4*)(lnb + col + 4); }
#pragma unroll
            for (int ai = 0; ai < 2; ++ai) {
                f32x4 xv[4][2]; f32x2 st[4];
#pragma unroll
                for (int m = 0; m < 4; ++m) { const int row = u.pm * 256 + ai * 128 + wr * 64 + m * 16 + fr;
                    const GAS f32x4* p = (const GAS f32x4*)(Xr + (size_t)row * D + col); xv[m][0] = p[0]; xv[m][1] = p[1];
                    if (LN) st[m] = *(const GAS f32x2*)(stats + 2 * row); }
#pragma unroll
                for (int m = 0; m < 4; ++m) { const int row = u.pm * 256 + ai * 128 + wr * 64 + m * 16 + fr;
                    GAS f32x4* p = (GAS f32x4*)(X + (size_t)row * D + col);
                    f32x4 x0 = xv[m][0], x1 = xv[m][1];
                    if (LN) { x0 = (x0 - st[m].x) * st[m].y * g0 + b0; x1 = (x1 - st[m].x) * st[m].y * g1 + b1; }
                    p[0] = x0 * ALPHA + acc[ai][bj][m][0] * s; p[1] = x1 * ALPHA + acc[ai][bj][m][1] * s; } } }
    }
};
__device__ __forceinline__ void phase_scale_unused(Frame& F, float* X) {
    const size_t n4 = (size_t)M * D / 4;
    const int tid = opaque_tid();
    for (size_t i = (size_t)blockIdx.x * NTHR + tid; i < n4; i += (size_t)F.G * NTHR) { GAS f32x4* p = (GAS f32x4*)X + i; *p = *p * ALPHA; }
}


__device__ __forceinline__ u32x4 pack8(const f32x4 a, const f32x4 b) { u32x4 w; w.x = pk2(a[0], a[1]); w.y = pk2(a[2], a[3]); w.z = pk2(b[0], b[1]); w.w = pk2(b[2], b[3]); return w; }
__device__ __forceinline__ u32x4 pack8h(const f32x4 a, const f32x4 b) { u32x4 w; w.x = pk2h(a[0], a[1]); w.y = pk2h(a[2], a[3]); w.z = pk2h(b[0], b[1]); w.w = pk2h(b[2], b[3]); return w; }
__device__ __forceinline__ void unpack8(const u32x4 w, f32x4& a, f32x4& b) { a = (f32x4){bflo(w.x), bfhi(w.x), bflo(w.y), bfhi(w.y)}; b = (f32x4){bflo(w.z), bfhi(w.z), bflo(w.w), bfhi(w.w)}; }
#define EPI_ROWS_BEGIN _Pragma("unroll") for (int ai = 0; ai < 2; ++ai) _Pragma("unroll") for (int m = 0; m < 4; ++m) { const int row = u.pm * 256 + ai * 128 + wr * 64 + m * 16 + fr; _Pragma("unroll") for (int bj = 0; bj < 2; ++bj) { \
    const int col = u.pn * 256 + bj * 128 + wc * 32 + 8 * fq; f32x4 v0 = acc[ai][bj][m][0], v1 = acc[ai][bj][m][1];
#define EPI_ROWS_END } }
#define EPI_ARGS const f32x4 (&acc)[2][2][4][2], const Unit& u, int wr, int wc, int fr_, int fq_
#define EPI_LANE const int l__ = fresh_lane(), fr = l__ & 15, fq = l__ >> 4; (void)fr_; (void)fq_;

struct EpiBf16 {
    bf16* O; int ldc, ncol, nrow;
    __device__ __forceinline__ void operator()(EPI_ARGS) const { EPI_LANE
        EPI_ROWS_BEGIN
            if (col < ncol && row < nrow) *(GAS u32x4*)(O + (size_t)row * ldc + col) = pack8h(v0, v1);
        EPI_ROWS_END
    }
};
struct EpiBf16Quarter {
    bf16* O; int ldc, p;
    __device__ __forceinline__ void operator()(EPI_ARGS) const { EPI_LANE
        EPI_ROWS_BEGIN
            if ((col >> 6) == p) *(GAS u32x4*)(O + (size_t)row * ldc + col) = pack8h(v0, v1);
        EPI_ROWS_END
    }
};
struct EpiSigmoid {
    bf16* O; int ldc;
    __device__ __forceinline__ void operator()(EPI_ARGS) const { EPI_LANE
        EPI_ROWS_BEGIN
#pragma unroll
            for (int j = 0; j < 4; ++j) { v0[j] = sigmoidf_(v0[j]); v1[j] = sigmoidf_(v1[j]); }
            *(GAS u32x4*)(O + (size_t)row * ldc + col) = pack8h(v0, v1);
        EPI_ROWS_END
    }
};
struct EpiCmp1 {
    bf16* O; const float* bias;
    __device__ __forceinline__ void operator()(EPI_ARGS) const { EPI_LANE
        EPI_ROWS_BEGIN
            const f32x4 b0 = *(const GAS f32x4*)(bias + col), b1 = *(const GAS f32x4*)(bias + col + 4);
#pragma unroll
            for (int j = 0; j < 4; ++j) { v0[j] = gelu_tanh(v0[j] + b0[j]); v1[j] = gelu_tanh(v1[j] + b1[j]); }
            *(GAS u32x4*)(O + (size_t)row * 256 + col) = ((row & 255) == 255) ? (u32x4){0u, 0u, 0u, 0u} : pack8h(v0, v1);
        EPI_ROWS_END
    }
};
constexpr float QSCALE = 0.07216878364870322f * 1.4426950408889634f;
struct EpiInA {
    float* LG; bf16* GU; bf16* QB; bf16* K3; bf16* VC;
    __device__ __forceinline__ void operator()(EPI_ARGS) const { EPI_LANE
        const int pn = u.pn;
        if (pn < 2) {
            EPI_ROWS_BEGIN
                GAS f32x4* p = (GAS f32x4*)(LG + (size_t)row * 512 + col); p[0] = v0; p[1] = v1;
            EPI_ROWS_END
        } else if (pn < 18) {
            EPI_ROWS_BEGIN
#pragma unroll
                for (int j = 0; j < 4; ++j) { v0[j] = gelu_tanh(v0[j]); v1[j] = gelu_tanh(v1[j]); }
                *(GAS u32x4*)(GU + (size_t)row * 4096 + (col - 512)) = pack8h(v0, v1);
            EPI_ROWS_END
        } else if (pn < 30) {
            EPI_ROWS_BEGIN
                *(GAS u32x4*)(QB + (size_t)row * 3072 + (col - 4608)) = pack8h(v0 * QSCALE, v1 * QSCALE);
            EPI_ROWS_END
        } else if (pn < 39) {
            EPI_ROWS_BEGIN
                const int e = col - 7680, ty = e / 768, cg = e - ty * 768, gg = cg / 192, dd = cg - gg * 192, bb = row >> 12, tt = row & 4095;
                *(GAS u32x4*)(K3 + ((size_t)((ty * 4 + bb) * 4 + gg) * T + tt) * 192 + dd) = pack8h(v0, v1);
            EPI_ROWS_END
        } else {
            EPI_ROWS_BEGIN
                const int e = col - 9984, gg = e >> 7, dd = e & 127, bb = row >> 12, tt = row & 4095;
                *(GAS u32x4*)(VC + ((size_t)(bb * 4 + gg) * T + tt) * 128 + dd) = pack8h(v0, v1);
            EPI_ROWS_END
        }
    }
};
struct EpiLoraWA {
    float* DEC; bf16* AG; const float* w0; const float* a0;
    __device__ __forceinline__ void operator()(EPI_ARGS) const { EPI_LANE
        if (u.pn < 8) {
            EPI_ROWS_BEGIN
                const f32x4 b0 = *(const GAS f32x4*)(w0 + col), b1 = *(const GAS f32x4*)(w0 + col + 4);
#pragma unroll
                for (int j = 0; j < 4; ++j) {
                    v0[j] = __expf(-0.60653065971263342f * sigmoidf_(v0[j] + b0[j]));
                    v1[j] = __expf(-0.60653065971263342f * sigmoidf_(v1[j] + b1[j])); }
                GAS f32x4* p = (GAS f32x4*)(DEC + (size_t)row * D + col); p[0] = v0; p[1] = v1;
            EPI_ROWS_END
        } else {
            EPI_ROWS_BEGIN
                const int c = col - 2048;
                const f32x4 b0 = *(const GAS f32x4*)(a0 + c), b1 = *(const GAS f32x4*)(a0 + c + 4);
#pragma unroll
                for (int j = 0; j < 4; ++j) { v0[j] = sigmoidf_(v0[j] + b0[j]); v1[j] = sigmoidf_(v1[j] + b1[j]); }
                *(GAS u32x4*)(AG + (size_t)row * D + c) = pack8h(v0, v1);
            EPI_ROWS_END
        }
    }
};
struct EpiVmix {
    bf16* VS; const bf16* VF; const float* v0b;
    __device__ __forceinline__ void operator()(EPI_ARGS) const { EPI_LANE
        EPI_ROWS_BEGIN
            const f32x4 b0 = *(const GAS f32x4*)(v0b + col), b1 = *(const GAS f32x4*)(v0b + col + 4);
            f32x4 s0, s1, f0, f1; unpack8(*(const GAS u32x4*)(VS + (size_t)row * D + col), s0, s1); unpack8(*(const GAS u32x4*)(VF + (size_t)row * D + col), f0, f1);
#pragma unroll
            for (int j = 0; j < 4; ++j) { v0[j] = s0[j] + (f0[j] - s0[j]) * sigmoidf_(v0[j] + b0[j]); v1[j] = s1[j] + (f1[j] - s1[j]) * sigmoidf_(v1[j] + b1[j]); }
            *(GAS u32x4*)(VS + (size_t)row * D + col) = pack8h(v0, v1);
        EPI_ROWS_END
    }
};
template <int MODE> struct EpiMerge {
    float* M32; bf16* MB; const bf16* G;
    __device__ __forceinline__ void operator()(EPI_ARGS) const { EPI_LANE
        EPI_ROWS_BEGIN
            f32x4 g0, g1; unpack8(*(const GAS u32x4*)(G + (size_t)row * 6144 + col), g0, g1);
            v0 = v0 * g0; v1 = v1 * g1;
            GAS u32x4* p = (GAS u32x4*)(MB + (size_t)row * D + col);
            if (MODE >= 1) { f32x4 p0, p1; unpack8(*p, p0, p1); v0 += p0; v1 += p1; }
            *p = pack8h(v0, v1);
        EPI_ROWS_END
    }
};

template <class F_> __device__ __forceinline__ void small_convert(const Frame& F, int tid, bf16* dst, int rows, int dk, F_ val) {
    const int total = rows * (dk / 8);
    for (int e = F.bx * NTHR + tid; e < total; e += F.G * NTHR) { const int kc = e / rows, n = e - kc * rows, k0 = kc * 8;
        u32x4 o; o.x = pk2(val(n, k0), val(n, k0 + 1)); o.y = pk2(val(n, k0 + 2), val(n, k0 + 3)); o.z = pk2(val(n, k0 + 4), val(n, k0 + 5)); o.w = pk2(val(n, k0 + 6), val(n, k0 + 7));
        *(GAS u32x4*)(dst + (size_t)n * dk + k0) = o; }
}
__device__ __forceinline__ void phase_convert_small(int wv, int l) {
    const Frame F = mkframe(wv); unsigned char* ws = wsptr(F); const int tid = F.tid;
    { const float* w2 = inptr(F, 4) + (size_t)l * 96 * D; const float* a2 = inptr(F, 6) + (size_t)l * 96 * D;
      small_convert(F, tid, (bf16*)(ws + WS_LWA), 4096, 256, [=](int n, int k) { return n < 2048 ? (k < 96 ? w2[(size_t)k * D + n] : 0.f) : ((k >= 96 && k < 192) ? a2[(size_t)(k - 96) * D + (n - 2048)] : 0.f); }); }
    { const float* g2 = inptr(F, 7) + (size_t)l * 256 * D;
      small_convert(F, tid, (bf16*)(ws + WS_LG2), 2048, 256, [=](int n, int k) { return g2[(size_t)k * D + n]; }); }
    if (l > 0) {
      const float* v1 = inptr(F, 9) + (size_t)(l - 1) * D * 64; const float* v2 = inptr(F, 10) + (size_t)(l - 1) * 64 * D;
      small_convert(F, tid, (bf16*)(ws + WS_LV1), 256, 2048, [=](int n, int k) { return (k >> 9) == (n >> 6) ? v1[(size_t)k * 64 + (n & 63)] : 0.f; });
      small_convert(F, tid, (bf16*)(ws + WS_LV2), 2048, 256, [=](int n, int k) { return v2[(size_t)(k & 63) * D + n]; }); }
    { const float* k1 = inptr(F, 22) + (size_t)l * 6144 * 192; const float* k2 = inptr(F, 23) + (size_t)l * 192 * 192;
      const float* v1 = inptr(F, 24) + (size_t)l * 4096 * 128; const float* v2 = inptr(F, 25) + (size_t)l * 128 * 128;
      small_convert(F, tid, (bf16*)(ws + WS_PK1), 256, 6144, [=](int n, int k) { return n < 192 ? k1[(size_t)k * 192 + n] : 0.f; });
      small_convert(F, tid, (bf16*)(ws + WS_PK2), 256, 256, [=](int n, int k) { return (n < 192 && k < 192) ? k2[(size_t)k * 192 + n] : 0.f; });
      small_convert(F, tid, (bf16*)(ws + WS_PV1), 256, 4096, [=](int n, int k) { return n < 128 ? v1[(size_t)k * 128 + n] : 0.f; });
      small_convert(F, tid, (bf16*)(ws + WS_PV2), 256, 256, [=](int n, int k) { return (n < 128 && k < 128) ? v2[(size_t)k * 128 + n] : 0.f; });
      float* b1 = (float*)(ws + WS_B1) + l * 512;
      const float* pk = inptr(F, 20) + (size_t)l * 6144; const float* pv = inptr(F, 21) + (size_t)l * 4096;
      for (int o = F.bx * NWAVES + F.wave; o < 320; o += F.G * NWAVES) {
          float sacc = 0.f;
          if (o < 192) { for (int j = F.lane; j < 6144; j += 64) sacc += pk[j] * k1[(size_t)j * 192 + o]; }
          else { for (int j = F.lane; j < 4096; j += 64) sacc += pv[j] * v1[(size_t)j * 128 + (o - 192)]; }
          sacc = wave_sum(sacc, F.lane);
          if (F.lane == 0) b1[o < 192 ? o : 256 + (o - 192)] = sacc;
      }
    }
}

__device__ __forceinline__ void phase_gm_stats(int wv) {
    const Frame F = mkframe(wv); unsigned char* ws = wsptr(F); const int lane = F.lane, wave = F.wave;
    const bf16* GU = (const bf16*)(ws + WS_GU); float* GST = (float*)(ws + WS_GST);
    const int NGW = F.G * NWAVES;
    for (int row0 = F.vcu * NWAVES + wave; row0 < M; row0 += 4 * NGW) {
        u32x4 raw[4][4];
#pragma unroll
        for (int r = 0; r < 4; ++r) { const int row = min(row0 + r * NGW, M - 1); const GAS u32x4* p = (const GAS u32x4*)(GU + (size_t)row * 4096 + 2048) + lane;
#pragma unroll
            for (int j = 0; j < 4; ++j) raw[r][j] = p[64 * j]; }
#pragma unroll
        for (int r = 0; r < 4; ++r) { const int row = row0 + r * NGW;
            f32x4 v[8]; float s = 0.f;
#pragma unroll
            for (int j = 0; j < 4; ++j) unpack8(raw[r][j], v[2 * j], v[2 * j + 1]);
#pragma unroll
            for (int j = 0; j < 8; ++j) s += (v[j][0] + v[j][1]) + (v[j][2] + v[j][3]);
            const float mean = wave_sum(s, lane) * (1.f / 2048.f); float s2 = 0.f;
#pragma unroll
            for (int j = 0; j < 8; ++j) { const f32x4 d = v[j] - mean; s2 += (d[0] * d[0] + d[1] * d[1]) + (d[2] * d[2] + d[3] * d[3]); }
            const float rstd = 1.f / sqrtf(wave_sum(s2, lane) * (1.f / 2048.f) + LN_EPS);
            if (lane == 0 && row < M) { GST[2 * row] = mean; GST[2 * row + 1] = rstd; } }
    }
}

__device__ __forceinline__ void phase_gmlp(int wv, int l) {
    const Frame F = mkframe(wv); unsigned char* ws = wsptr(F); const int tid = F.tid, lane = F.lane, wave = F.wave, fr = lane & 15, fq = lane >> 4;
    const bf16* GU = (const bf16*)(ws + WS_GU); const float* GST = (const float*)(ws + WS_GST); bf16* YGM = (bf16*)(ws + WS_YGM);
    const float* lng = inptr(F, 16) + (size_t)l * D; const float* lnb = inptr(F, 17) + (size_t)l * D;
    const float* gws = inptr(F, 18) + (size_t)l * 16 * 128 * 128; const float* gbs = inptr(F, 19) + (size_t)l * 16 * 128;
    LAS unsigned char* VTl = F.lds; LAS unsigned char* Wl = F.lds + 34816;
    const int s_ = tid >> 2, cq = tid & 3;
    int g_staged = -1;
    u32x4 vraw[4]; float mean, rstd;
    { const int uid = min(F.vcu, 2047); const int g = uid & 15, c = (uid >> 4) & 31, b = uid >> 9; const int token = b * T + c * 128 + s_;
      mean = GST[2 * token]; rstd = GST[2 * token + 1];
#pragma unroll
      for (int i = 0; i < 4; ++i) vraw[i] = *(const GAS u32x4*)(GU + (size_t)token * 4096 + 2048 + g * 128 + cq * 8 + 32 * i); }
    for (int uid = F.vcu; uid < 2048; uid += F.G) {
        const int g = uid & 15, c = (uid >> 4) & 31, b = uid >> 9;
        const int tok0 = b * T + c * 128;
        {
#pragma unroll
            for (int i = 0; i < 4; ++i) { const int ch = cq * 8 + 32 * i; f32x4 a, bq; unpack8(vraw[i], a, bq);
                const f32x4 g0 = *(const GAS f32x4*)(lng + g * 128 + ch), g1 = *(const GAS f32x4*)(lng + g * 128 + ch + 4), b0 = *(const GAS f32x4*)(lnb + g * 128 + ch), b1 = *(const GAS f32x4*)(lnb + g * 128 + ch + 4);
                a = (a - mean) * rstd * g0 + b0; bq = (bq - mean) * rstd * g1 + b1;
#pragma unroll
                for (int j = 0; j < 4; ++j) { *(LAS unsigned short*)(VTl + (ch + j) * 272 + s_ * 2) = (unsigned short)f2bf(a[j]); *(LAS unsigned short*)(VTl + (ch + 4 + j) * 272 + s_ * 2) = (unsigned short)f2bf(bq[j]); } }
            if (g != g_staged) {
                g_staged = g;
                const float* wrow = gws + ((size_t)g * 128 + s_) * 128 + cq * 32;
#pragma unroll
                for (int i = 0; i < 4; ++i) { f32x4 a = *(const GAS f32x4*)(wrow + 8 * i), bq = *(const GAS f32x4*)(wrow + 8 * i + 4);
#pragma unroll
                    for (int j = 0; j < 4; ++j) { if (cq * 32 + 8 * i + j > s_) a[j] = 0.f; if (cq * 32 + 8 * i + 4 + j > s_) bq[j] = 0.f; }
                    *(LAS u32x4*)(Wl + s_ * 272 + (cq * 32 + 8 * i) * 2) = pack8(a, bq); } }
        }
        __syncthreads();
        const int tl = 16 * wave + fr, token = tok0 + tl;
        u32x2 uu[8]; const float bias = gbs[g * 128 + tl];
#pragma unroll
        for (int dt = 0; dt < 8; ++dt) uu[dt] = *(const GAS u32x2*)(GU + (size_t)token * 4096 + g * 128 + 16 * dt + 4 * fq);
        { const int un = min(uid + F.G, 2047); const int gn = un & 15, cn = (un >> 4) & 31, bn = un >> 9; const int tokn = bn * T + cn * 128 + s_;
          mean = GST[2 * tokn]; rstd = GST[2 * tokn + 1];
#pragma unroll
          for (int i = 0; i < 4; ++i) vraw[i] = *(const GAS u32x4*)(GU + (size_t)tokn * 4096 + 2048 + gn * 128 + cq * 8 + 32 * i); }
        f32x4 acc[8];
#pragma unroll
        for (int dt = 0; dt < 8; ++dt) acc[dt] = (f32x4){0.f, 0.f, 0.f, 0.f};
#pragma unroll
        for (int ks = 0; ks < 4; ++ks) { const bf16x8 wf = *(const LAS bf16x8*)(Wl + (16 * wave + fr) * 272 + (32 * ks + 8 * fq) * 2);
#pragma unroll
            for (int dt = 0; dt < 8; ++dt) { const bf16x8 vf = *(const LAS bf16x8*)(VTl + (16 * dt + fr) * 272 + (32 * ks + 8 * fq) * 2);
                acc[dt] = __builtin_amdgcn_mfma_f32_16x16x32_bf16(vf, wf, acc[dt], 0, 0, 0); } }
#pragma unroll
        for (int dt = 0; dt < 8; ++dt) { const int d0 = 16 * dt + 4 * fq;
            u32x2 o; o.x = pk2(bflo(uu[dt].x) * (acc[dt][0] + bias), bfhi(uu[dt].x) * (acc[dt][1] + bias)); o.y = pk2(bflo(uu[dt].y) * (acc[dt][2] + bias), bfhi(uu[dt].y) * (acc[dt][3] + bias));
            *(GAS u32x2*)(YGM + (size_t)token * D + g * 128 + d0) = o; }
        asm volatile("s_waitcnt lgkmcnt(0)" ::: "memory"); __builtin_amdgcn_s_barrier(); asm volatile("" ::: "memory");
    }
}
__device__ __forceinline__ void phase_zero(int wv, size_t off) {
    const Frame F = mkframe(wv); bf16* p = (bf16*)(wsptr(F) + off); const int tid = F.tid; const size_t n = (size_t)M * D / 8;
    for (size_t i = (size_t)F.bx * NTHR + tid; i < n; i += (size_t)F.G * NTHR) ((GAS u32x4*)p)[i] = (u32x4){0u, 0u, 0u, 0u};
}


constexpr int AT_KB = 0, AT_KSZ = 24576, AT_VB = 2 * AT_KSZ, AT_VSZ = 16384, AT_IMPA = AT_VB + 2 * AT_VSZ, AT_IMPB = AT_IMPA + 16384, AT_MASK = AT_IMPB + 16384, AT_END = AT_MASK + 512;
static_assert(AT_END <= RING_BYTES, "attention LDS");
struct AttnStage { unsigned koff[3], voff[2]; };
__device__ __forceinline__ void at_offsets(AttnStage& t, int wave, int lane, int vpitch) {
#pragma unroll
    for (int q = 0; q < 3; ++q) { const int P = (3 * wave + q) * 64 + lane, r = P / 24, cs = P - r * 24, c = cs ^ ((r >> 1) & 7); t.koff[q] = (unsigned)(r * 24 + c) * 16u; }
#pragma unroll
    for (int q = 0; q < 2; ++q) { const int P = (2 * wave + q) * 64 + lane, r = P >> 3, cs = P & 7, c = cs ^ ((r >> 1) & 7); t.voff[q] = (unsigned)(r * vpitch) * 2u + (unsigned)c * 16u; }
}
__device__ __forceinline__ void at_issue(const AttnStage& t, int wave, const bf16* kt, const bf16* vt, LAS unsigned char* kb, LAS unsigned char* vb) {
#pragma unroll
    for (int q = 0; q < 3; ++q) __builtin_amdgcn_global_load_lds((const unsigned*)((const char*)kt + t.koff[q]), (LAS unsigned*)(kb + (3 * wave + q) * 1024), 16, 0, 0);
#pragma unroll
    for (int q = 0; q < 2; ++q) __builtin_amdgcn_global_load_lds((const unsigned*)((const char*)vt + t.voff[q]), (LAS unsigned*)(vb + (2 * wave + q) * 1024), 16, 0, 0);
}
template <int MODE, int AMASK = 3>
__device__ __forceinline__ void attn_step(const LAS unsigned char* Kl, const LAS unsigned char* Vl, const bf16x8 (&qf)[2][6], float (&m)[2], float (&l)[2], f32x4 (&O)[8][2],
                                          const int (&lo)[2], const int (&hi)[2], int lane, int fr, int fq, LAS float* impA, LAS float* impB, int sbase) {
    f32x4 st[2][4];
#pragma unroll
    for (int a = 0; a < 2; ++a)
#pragma unroll
        for (int nt = 0; nt < 4; ++nt) st[a][nt] = (f32x4){0.f, 0.f, 0.f, 0.f};
    const int sw = (fr >> 1) & 7, swb = sw >> 2;
    const LAS unsigned char* kbase0 = Kl + fr * 384 + ((fq ^ (sw & 3)) << 4);
    const LAS unsigned char* kb_e = kbase0 + 64 * swb; const LAS unsigned char* kb_o = kbase0 + 64 * (1 - swb);
#define AT_LDK(e) (*(const LAS bf16x8*)(((((e) >> 2) & 1) ? kb_o : kb_e) + 128 * ((e) >> 3) + 6144 * ((e) & 3)))
    { bf16x8 kfr[3]; kfr[0] = AT_LDK(0); kfr[1] = AT_LDK(1);
#pragma unroll
      for (int e = 0; e < 24; ++e) { const int ks = e >> 2, nt = e & 3;
          if (e + 2 < 24) kfr[(e + 2) % 3] = AT_LDK(e + 2);
          if (AMASK & 1) st[0][nt] = __builtin_amdgcn_mfma_f32_16x16x32_bf16(kfr[e % 3], qf[0][ks], st[0][nt], 0, 0, 0);
          if (AMASK & 2) st[1][nt] = __builtin_amdgcn_mfma_f32_16x16x32_bf16(kfr[e % 3], qf[1][ks], st[1][nt], 0, 0, 0);
          __builtin_amdgcn_sched_barrier(0); } }
#undef AT_LDK
    const bool rnone0 = hi[0] < lo[0] || hi[0] < 0 || lo[0] > 63, rnone1 = hi[1] < lo[1] || hi[1] < 0 || lo[1] > 63;
    const bool rcut0 = !rnone0 && !(lo[0] <= 0 && hi[0] >= 63), rcut1 = !rnone1 && !(lo[1] <= 0 && hi[1] >= 63);
    float alpha2[2] = {1.f, 1.f};
    if (!__any(((AMASK & 1) && rcut0) || ((AMASK & 2) && rcut1))) {
#pragma unroll
        for (int a = 0; a < 2; ++a) { if (!(AMASK & (1 << a))) continue; const bool rnone = a ? rnone1 : rnone0;
            float mx = fmaxf(fmaxf(fmaxf(st[a][0][0], st[a][0][1]), fmaxf(st[a][0][2], st[a][0][3])), fmaxf(fmaxf(st[a][1][0], st[a][1][1]), fmaxf(st[a][1][2], st[a][1][3])));
            mx = fmaxf(mx, fmaxf(fmaxf(fmaxf(st[a][2][0], st[a][2][1]), fmaxf(st[a][2][2], st[a][2][3])), fmaxf(fmaxf(st[a][3][0], st[a][3][1]), fmaxf(st[a][3][2], st[a][3][3]))));
            mx = rnone ? -1e30f : mx;
            if (MODE != 1) { mx = fmaxf(mx, xlane(mx, lane ^ 16)); mx = fmaxf(mx, xlane(mx, lane ^ 32)); const float mn = fmaxf(m[a], mx); alpha2[a] = __builtin_amdgcn_exp2f(m[a] - mn); m[a] = mn; }
            const float meff = rnone ? 3e38f : m[a];
            float rs = 0.f;
#pragma unroll
            for (int nt = 0; nt < 4; ++nt)
#pragma unroll
                for (int j = 0; j < 4; ++j) { float p = __builtin_amdgcn_exp2f(st[a][nt][j] - meff); if (MODE == 1) p *= l[a]; st[a][nt][j] = p; rs += p; }
            if (MODE != 1) { rs += xlane(rs, lane ^ 16); rs += xlane(rs, lane ^ 32); l[a] = l[a] * alpha2[a] + rs; } }
    } else {
#pragma unroll
        for (int a = 0; a < 2; ++a) { if (!(AMASK & (1 << a))) continue;
            float mx = -1e30f; const int lo_ = lo[a] - 4 * fq, hi_ = hi[a] - 4 * fq;
#pragma unroll
            for (int nt = 0; nt < 4; ++nt)
#pragma unroll
                for (int j = 0; j < 4; ++j) { const float sv = (16 * nt + j >= lo_ && 16 * nt + j <= hi_) ? st[a][nt][j] : -1e30f; st[a][nt][j] = sv; mx = fmaxf(mx, sv); }
            if (MODE != 1) { mx = fmaxf(mx, xlane(mx, lane ^ 16)); mx = fmaxf(mx, xlane(mx, lane ^ 32)); const float mn = fmaxf(m[a], mx); alpha2[a] = __builtin_amdgcn_exp2f(m[a] - mn); m[a] = mn; }
            float rs = 0.f;
#pragma unroll
            for (int nt = 0; nt < 4; ++nt)
#pragma unroll
                for (int j = 0; j < 4; ++j) { float p = st[a][nt][j] > -5e29f ? __builtin_amdgcn_exp2f(st[a][nt][j] - m[a]) : 0.f; if (MODE == 1) p *= l[a]; st[a][nt][j] = p; rs += p; }
            if (MODE != 1) { rs += xlane(rs, lane ^ 16); rs += xlane(rs, lane ^ 32); l[a] = l[a] * alpha2[a] + rs; } }
    }
    if (MODE == 2) { if (__any(alpha2[0] != 1.f || alpha2[1] != 1.f)) {
#pragma unroll
        for (int dt = 0; dt < 8; ++dt) { O[dt][0] = O[dt][0] * alpha2[0]; O[dt][1] = O[dt][1] * alpha2[1]; } } }
    if (MODE == 0) return;
    bf16x8 pf[2][2];
#pragma unroll
    for (int a = 0; a < 2; ++a)
#pragma unroll
        for (int kk = 0; kk < 2; ++kk) { if (!(AMASK & (1 << a))) continue; const u32x4 w = pack8h(st[a][2 * kk], st[a][2 * kk + 1]); pf[a][kk] = __builtin_bit_cast(bf16x8, w); }
    const int o0 = (fq >> 1) ^ (sw & 3);
    const LAS unsigned char* vrow = Vl + fr * 128 + 8 * (fq & 1);
    const LAS unsigned char* va[2][2] = {{vrow + 64 * swb + 16 * o0, vrow + 64 * swb + 16 * (o0 ^ 2)}, {vrow + 64 * (1 - swb) + 16 * o0, vrow + 64 * (1 - swb) + 16 * (o0 ^ 2)}};
#define AT_LDV(e, dst) do { const u32x2 v0_ = *(const LAS u32x2*)(va[(e) & 1][0] + 2048 * ((e) >> 1)), v1_ = *(const LAS u32x2*)(va[(e) & 1][1] + 2048 * ((e) >> 1)); dst = (u32x4){v0_.x, v0_.y, v1_.x, v1_.y}; } while (0)
    { u32x4 vfr[3]; AT_LDV(0, vfr[0]); AT_LDV(1, vfr[1]);
#pragma unroll
      for (int e = 0; e < 16; ++e) { const int dt = e >> 1, kk = e & 1;
          if (e + 2 < 16) AT_LDV(e + 2, vfr[(e + 2) % 3]);
          const bf16x8 vf = __builtin_bit_cast(bf16x8, vfr[e % 3]);
          if (AMASK & 1) O[dt][0] = __builtin_amdgcn_mfma_f32_16x16x32_bf16(vf, pf[0][kk], O[dt][0], 0, 0, 0);
          if (AMASK & 2) O[dt][1] = __builtin_amdgcn_mfma_f32_16x16x32_bf16(vf, pf[1][kk], O[dt][1], 0, 0, 0);
          __builtin_amdgcn_sched_barrier(0); } }
#undef AT_LDV
    if (MODE == 1) {
#pragma unroll
        for (int a = 0; a < 2; ++a)
#pragma unroll
            for (int nt = 0; nt < 4; ++nt) { f32x4 h = st[a][nt];
#pragma unroll
                for (int j = 0; j < 4; ++j) { h[j] += dpp<0xB1>(h[j]); h[j] += dpp<0x4E>(h[j]); }
                if ((fr & 3) == 0) { const int tl = 4 * a + (fr >> 2), si = sbase + 4 * nt + fq;
                    impA[tl * 64 + si] = (h[0] + h[1]) + (h[2] + h[3]); if (si + 1 < 64) impB[tl * 64 + si + 1] = h[3]; } }
    }
}
struct NsaUnit { int b, g, qi, t0, wave; };
template <int MODE, int KIND>
__device__ __forceinline__ void attn_loop(LAS unsigned char* lds, const NsaUnit& U, int lane, int fr, int fq, const bf16* kbase, const bf16* vbase, int vpitch, int j0, int n,
                                          const int (&tokA)[2], const unsigned long long (&selm)[2], const bf16x8 (&qf)[2][6], float (&m)[2], float (&l)[2], f32x4 (&O)[8][2], LAS float* impA, LAS float* impB) {
    AttnStage stg; at_offsets(stg, U.wave, lane, vpitch);
    at_issue(stg, U.wave, kbase + (size_t)j0 * 64 * 192, vbase + (size_t)j0 * 64, lds + AT_KB, lds + AT_VB);
    asm volatile("s_waitcnt vmcnt(0)" ::: "memory");
    __syncthreads();
    for (int s = 0; s < n; ++s) {
        const int j = j0 + s, bsel = s & 1;
        if (s + 1 < n) at_issue(stg, U.wave, kbase + (size_t)(j + 1) * 64 * 192, vbase + (size_t)(j + 1) * 64, lds + AT_KB + (bsel ^ 1) * AT_KSZ, lds + AT_VB + (bsel ^ 1) * AT_VSZ);
        int lo[2], hi[2];
#pragma unroll
        for (int a = 0; a < 2; ++a) {
            if (KIND == 0) { lo[a] = 0; hi[a] = ((U.t0 + tokA[a] - 31) >> 4) - 64 * j; }
            else if (KIND == 1) { lo[a] = 0; hi[a] = (j == U.qi) ? tokA[a] : (((selm[a] >> j) & 1ull) ? 63 : -1); }
            else { lo[a] = (j == U.qi - 8) ? tokA[a] + 1 : 0; hi[a] = (j == U.qi) ? tokA[a] : 63; }
        }
        if (KIND == 1) { const bool a0 = __any(hi[0] >= 0), a1 = __any(hi[1] >= 0);
            if (a0 && a1) attn_step<MODE, 3>(lds + AT_KB + bsel * AT_KSZ, lds + AT_VB + bsel * AT_VSZ, qf, m, l, O, lo, hi, lane, fr, fq, impA, impB, 16 * j);
            else if (a0) attn_step<MODE, 1>(lds + AT_KB + bsel * AT_KSZ, lds + AT_VB + bsel * AT_VSZ, qf, m, l, O, lo, hi, lane, fr, fq, impA, impB, 16 * j);
            else if (a1) attn_step<MODE, 2>(lds + AT_KB + bsel * AT_KSZ, lds + AT_VB + bsel * AT_VSZ, qf, m, l, O, lo, hi, lane, fr, fq, impA, impB, 16 * j); }
        else attn_step<MODE, 3>(lds + AT_KB + bsel * AT_KSZ, lds + AT_VB + bsel * AT_VSZ, qf, m, l, O, lo, hi, lane, fr, fq, impA, impB, 16 * j);
        asm volatile("s_waitcnt vmcnt(0)" ::: "memory");
        __syncthreads();
    }
}
#define NSA_GATE2(tA_, j) sigmoidf_(LG[(size_t)(U.b * T + U.t0 + (tA_)) * 512 + 448 + (U.g * 4 + (fr2 & 3)) * 3 + (j)])
__device__ __forceinline__ void nsa_cmp_branch(LAS unsigned char* lds, unsigned char* ws, const NsaUnit& U, const bf16x8 (&qf)[2][6]) {
    const int lane = fresh_lane(), fr = lane & 15, fq = lane >> 4;
    int tokA[2]; tokA[0] = 8 * U.wave + (fr >> 2); tokA[1] = tokA[0] + 4;
    LAS float* impA = (LAS float*)(lds + AT_IMPA) + U.wave * 512; LAS float* impB = (LAS float*)(lds + AT_IMPB) + U.wave * 512;
    for (int e = lane; e < 512; e += 64) { impA[e] = 0.f; impB[e] = 0.f; }
    const unsigned long long selm[2] = {0ull, 0ull};
    float m[2], l[2]; f32x4 O[8][2];
    const int nkt = ((4 * U.qi + 2) >> 6) + 1, bg = U.b * 4 + U.g;
    const bf16* kc = (const bf16*)(ws + WS_KCMP) + (size_t)bg * 256 * 192; const bf16* vc = (const bf16*)(ws + WS_VCMT) + (size_t)bg * 256;
    m[0] = m[1] = -1e30f; l[0] = l[1] = 0.f;
    attn_loop<0, 0>(lds, U, lane, fr, fq, kc, vc, 4096, 0, nkt, tokA, selm, qf, m, l, O, impA, impB);
    l[0] = l[0] > 0.f ? 1.f / l[0] : 0.f; l[1] = l[1] > 0.f ? 1.f / l[1] : 0.f;
#pragma unroll
    for (int dt = 0; dt < 8; ++dt) { O[dt][0] = (f32x4){0.f, 0.f, 0.f, 0.f}; O[dt][1] = (f32x4){0.f, 0.f, 0.f, 0.f}; }
    attn_loop<1, 0>(lds, U, lane, fr, fq, kc, vc, 4096, 0, nkt, tokA, selm, qf, m, l, O, impA, impB);
    const float* LG = (const float*)(ws + WS_LG); bf16* YNS = (bf16*)(ws + WS_YNS);
    const int lane2 = fresh_lane(), fr2 = lane2 & 15, fq2 = lane2 >> 4, tB = 8 * U.wave + (fr2 >> 2);
#pragma unroll
    for (int a = 0; a < 2; ++a) { bf16* yp = YNS + (size_t)(U.b * T + U.t0 + tB + 4 * a) * D + (U.g * 4 + (fr2 & 3)) * 128 + 4 * fq2; const float gc = NSA_GATE2(tB + 4 * a, 0);
#pragma unroll
        for (int dt = 0; dt < 8; ++dt) { const f32x4 y = O[dt][a] * gc; u32x2 o; o.x = pk2(y[0], y[1]); o.y = pk2(y[2], y[3]); *(GAS u32x2*)(yp + 16 * dt) = o; } }
}
__device__ __forceinline__ void nsa_topk(LAS unsigned char* lds, const NsaUnit& U) {
    const int lane = fresh_lane();
    LAS float* impA = (LAS float*)(lds + AT_IMPA) + U.wave * 512; LAS float* impB = (LAS float*)(lds + AT_IMPB) + U.wave * 512;
    LAS unsigned long long* masks = (LAS unsigned long long*)(lds + AT_MASK);
    LDS_WAIT(); asm volatile("" ::: "memory");
#pragma unroll 1
    for (int tl = 0; tl < 8; ++tl) {
        const int s_ = lane; const float imp = impA[tl * 64 + s_] + impB[tl * 64 + s_];
        const bool valid = s_ <= U.qi, forced = valid && (s_ == 0 || s_ == U.qi || s_ == U.qi - 1);
        const float sc = forced ? 1e6f : (valid ? imp : -1e30f);
        int rank = 0;
#pragma unroll 8
        for (int o = 0; o < 64; ++o) { const float so = __builtin_bit_cast(float, __builtin_amdgcn_readlane(__builtin_bit_cast(int, sc), o)); rank += (so > sc || (so == sc && o < s_)) ? 1 : 0; }
        const unsigned long long mk = __ballot(rank < 16 && sc > -5e29f);
        if (lane == 0) masks[U.wave * 8 + tl] = mk;
    }
    LDS_WAIT(); asm volatile("" ::: "memory");
}
template <int KIND>
__device__ __forceinline__ void nsa_online_branch(LAS unsigned char* lds, unsigned char* ws, const NsaUnit& U, const bf16x8 (&qf)[2][6]) {
    const int lane = fresh_lane(), fr = lane & 15, fq = lane >> 4;
    int tokA[2]; tokA[0] = 8 * U.wave + (fr >> 2); tokA[1] = tokA[0] + 4;
    LAS float* impA = (LAS float*)(lds + AT_IMPA); LAS float* impB = impA;
    const LAS unsigned long long* masks = (const LAS unsigned long long*)(lds + AT_MASK);
    unsigned long long selm[2]; selm[0] = masks[U.wave * 8 + (fr >> 2)]; selm[1] = masks[U.wave * 8 + 4 + (fr >> 2)];
    float m[2], l[2]; f32x4 O[8][2];
    m[0] = m[1] = -1e30f; l[0] = l[1] = 0.f;
#pragma unroll
    for (int dt = 0; dt < 8; ++dt) { O[dt][0] = (f32x4){0.f, 0.f, 0.f, 0.f}; O[dt][1] = (f32x4){0.f, 0.f, 0.f, 0.f}; }
    const bf16* K3 = (const bf16*)(ws + WS_K3); const bf16* VT = (const bf16*)(ws + WS_VT);
    const int j0 = (KIND == 2 && U.qi >= 8) ? U.qi - 8 : 0;
    attn_loop<2, KIND>(lds, U, lane, fr, fq, K3 + (size_t)((KIND * 4 + U.b) * 4 + U.g) * T * 192, VT + (size_t)((KIND - 1) * 512 + U.g * 128) * M + (size_t)U.b * T, M, j0, U.qi - j0 + 1,
                       tokA, selm, qf, m, l, O, impA, impB);
    const float* LG = (const float*)(ws + WS_LG); bf16* YNS = (bf16*)(ws + WS_YNS);
    const int lane2 = fresh_lane(), fr2 = lane2 & 15, fq2 = lane2 >> 4, tB = 8 * U.wave + (fr2 >> 2);
#pragma unroll
    for (int a = 0; a < 2; ++a) { const size_t off = (size_t)(U.b * T + U.t0 + tB + 4 * a) * D + (U.g * 4 + (fr2 & 3)) * 128 + 4 * fq2; const float sc = l[a] > 0.f ? NSA_GATE2(tB + 4 * a, KIND) / l[a] : 0.f;
#pragma unroll
        for (int dt = 0; dt < 8; ++dt) { const u32x2 pv = *(const GAS u32x2*)(YNS + off + 16 * dt); const f32x4 y = (f32x4){bflo(pv.x), bfhi(pv.x), bflo(pv.y), bfhi(pv.y)} + O[dt][a] * sc;
            u32x2 o; o.x = pk2(y[0], y[1]); o.y = pk2(y[2], y[3]); *(GAS u32x2*)(YNS + off + 16 * dt) = o; } }
}
__device__ __forceinline__ void phase_nsa_attn(int wv) {
    const Frame F = mkframe(wv); unsigned char* ws = wsptr(F);
#pragma unroll 1
    for (int r = 0; r < 4; ++r) {
        const int q = r * F.G + F.bx; if (q >= 1024) break;
        const int bg = q >> 6, ii = q & 63;
        NsaUnit U; U.qi = (r & 1) ? 63 - ii : ii; U.b = bg >> 2; U.g = bg & 3; U.t0 = 64 * U.qi; U.wave = F.wave;
        bf16x8 qf[2][6];
        { const int lane = fresh_lane(), fr = lane & 15, fq = lane >> 4; const bf16* QB = (const bf16*)(ws + WS_QB);
#pragma unroll
          for (int a = 0; a < 2; ++a)
#pragma unroll
            for (int ks = 0; ks < 6; ++ks) qf[a][ks] = *(const GAS bf16x8*)(QB + (size_t)(U.b * T + U.t0 + 8 * U.wave + 4 * a + (fr >> 2)) * 3072 + (U.g * 4 + (fr & 3)) * 192 + 32 * ks + 8 * fq); }
        nsa_cmp_branch(F.lds, ws, U, qf);
        nsa_topk(F.lds, U);
        nsa_online_branch<1>(F.lds, ws, U, qf);
        nsa_online_branch<2>(F.lds, ws, U, qf);
    }
}

template <int Q> __device__ __forceinline__ float fmac_qb(float acc, float x, float s) {
    if (Q == 0) asm("v_fmac_f32_dpp %0, %1, %2 quad_perm:[0,0,0,0] row_mask:0xf bank_mask:0xf" : "+v"(acc) : "v"(x), "v"(s));
    else if (Q == 1) asm("v_fmac_f32_dpp %0, %1, %2 quad_perm:[1,1,1,1] row_mask:0xf bank_mask:0xf" : "+v"(acc) : "v"(x), "v"(s));
    else if (Q == 2) asm("v_fmac_f32_dpp %0, %1, %2 quad_perm:[2,2,2,2] row_mask:0xf bank_mask:0xf" : "+v"(acc) : "v"(x), "v"(s));
    else asm("v_fmac_f32_dpp %0, %1, %2 quad_perm:[3,3,3,3] row_mask:0xf bank_mask:0xf" : "+v"(acc) : "v"(x), "v"(s));
    return acc;
}
template <int Q> __device__ __forceinline__ float mul_qb(float x, float s) {
    float d;
    if (Q == 0) asm("v_mul_f32_dpp %0, %1, %2 quad_perm:[0,0,0,0] row_mask:0xf bank_mask:0xf" : "=v"(d) : "v"(x), "v"(s));
    else if (Q == 1) asm("v_mul_f32_dpp %0, %1, %2 quad_perm:[1,1,1,1] row_mask:0xf bank_mask:0xf" : "=v"(d) : "v"(x), "v"(s));
    else if (Q == 2) asm("v_mul_f32_dpp %0, %1, %2 quad_perm:[2,2,2,2] row_mask:0xf bank_mask:0xf" : "=v"(d) : "v"(x), "v"(s));
    else asm("v_mul_f32_dpp %0, %1, %2 quad_perm:[3,3,3,3] row_mask:0xf bank_mask:0xf" : "=v"(d) : "v"(x), "v"(s));
    return d;
}
template <int HI> __device__ __forceinline__ float fmix(unsigned hp, float s, float acc) { float d;
    if (HI) asm("v_fma_mix_f32 %0, %1, %2, %3 op_sel:[1,0,0] op_sel_hi:[1,0,0]" : "=v"(d) : "v"(hp), "v"(s), "v"(acc));
    else asm("v_fma_mix_f32 %0, %1, %2, %3 op_sel_hi:[1,0,0]" : "=v"(d) : "v"(hp), "v"(s), "v"(acc));
    return d; }
__device__ __forceinline__ float allreduce8(float x) { x += dpp<0xB1>(x); x += dpp<0x4E>(x); x += dpp<0x141>(x); return x; }
__device__ __forceinline__ void phase_rw_e1(int wv, int l) {
    const Frame F = mkframe(wv); unsigned char* ws = wsptr(F); const int lane = F.lane;
    const float* LG = (const float*)(ws + WS_LG); const bf16* RKV = (const bf16*)(ws + WS_RKV); bf16* AL = (bf16*)(ws + WS_AL); bf16* VS = (bf16*)(ws + (l ? WS_VS1 : WS_VS0));
    const float* mu = inptr(F, 2) + (size_t)l * 6592;
    for (int row = F.vcu * NWAVES + F.wave; row < M; row += F.G * NWAVES) {
        const bool first = (row & (T - 1)) == 0;
        { f32x4 o0 = (f32x4){0.f, 0.f, 0.f, 0.f}, o1 = o0;
          if (lane < 24 || lane >= 32) { const int sc = lane < 24 ? 8 * lane : 8 * lane - 64;
              const f32x4 c0 = *(const GAS f32x4*)(LG + (size_t)row * 512 + sc), c1 = *(const GAS f32x4*)(LG + (size_t)row * 512 + sc + 4);
              f32x4 p0 = (f32x4){0.f, 0.f, 0.f, 0.f}, p1 = p0; if (!first) { p0 = *(const GAS f32x4*)(LG + (size_t)(row - 1) * 512 + sc); p1 = *(const GAS f32x4*)(LG + (size_t)(row - 1) * 512 + sc + 4); }
              const f32x4 m0 = *(const GAS f32x4*)(mu + 6144 + sc), m1 = *(const GAS f32x4*)(mu + 6144 + sc + 4);
              o0 = c0 + (p0 - c0) * m0; o1 = c1 + (p1 - c1) * m1;
              if (lane < 12) {
#pragma unroll
                  for (int j = 0; j < 4; ++j) { o0[j] = 1.f - 2.f / (1.f + __expf(2.f * o0[j])); o1[j] = 1.f - 2.f / (1.f + __expf(2.f * o1[j])); } }
              else if (lane >= 32) {
#pragma unroll
                  for (int j = 0; j < 4; ++j) { o0[j] = sigmoidf_(o0[j]); o1[j] = sigmoidf_(o1[j]); } } }
          *(GAS u32x4*)(AL + (size_t)row * 512 + 8 * lane) = pack8(o0, o1); }
#pragma unroll
        for (int i = 0; i < 4; ++i) { const int c = 8 * lane + 512 * i; f32x4 c0, c1, p0 = (f32x4){0.f, 0.f, 0.f, 0.f}, p1 = p0;
            unpack8(*(const GAS u32x4*)(RKV + (size_t)row * 6144 + 4096 + c), c0, c1);
            if (!first) unpack8(*(const GAS u32x4*)(RKV + (size_t)(row - 1) * 6144 + 4096 + c), p0, p1);
            const f32x4 m0 = *(const GAS f32x4*)(mu + 4096 + c), m1 = *(const GAS f32x4*)(mu + 4096 + c + 4);
            *(GAS u32x4*)(VS + (size_t)row * D + c) = pack8(c0 + (p0 - c0) * m0, c1 + (p1 - c1) * m1); }
    }
}
constexpr int SC_R = 0, SC_W = 4096, SC_K = 8192, SC_A = 12288, SC_B = 16384, SC_V = 20480, SC_BUF = 24576;
typedef _Float16 h16x8 __attribute__((ext_vector_type(8)));
#define SC_BARRIER() do { asm volatile("s_waitcnt lgkmcnt(0)" ::: "memory"); __builtin_amdgcn_s_barrier(); asm volatile("" ::: "memory"); } while (0)
__device__ __forceinline__ void phase_scan(int wv, int l) {
    const Frame F = mkframe(wv); unsigned char* ws = wsptr(F); const int lane = F.lane, wave = F.wave;
    const bf16* RKV = (const bf16*)(ws + WS_RKV); const bf16* VS = (const bf16*)(ws + (l ? WS_VS1 : WS_VS0)); const float* DEC = (const float*)(ws + WS_DEC); const bf16* AG = (const bf16*)(ws + WS_AG);
    float* YR = (float*)(ws + WS_YR); float* BON = (float*)(ws + WS_BON);
    const float* mu = inptr(F, 2) + (size_t)l * 6592; const float* kkp = inptr(F, 11) + (size_t)l * D; const float* kap = inptr(F, 12) + (size_t)l * D; const float* rkp = inptr(F, 13) + (size_t)l * D;
    for (int uid = F.bx; uid < 256; uid += F.G) {
        const int b = uid >> 6, h = (uid >> 1) & 31, half = uid & 1;
        if (wave >= 4) {
            const int ht = (wave - 4) * 64 + lane, t = ht >> 3, cg = ht & 7, ch = h * 64 + 8 * cg;
            f32x4 mr0 = *(const GAS f32x4*)(mu + ch), mr1 = *(const GAS f32x4*)(mu + ch + 4), mk0 = *(const GAS f32x4*)(mu + 2048 + ch), mk1 = *(const GAS f32x4*)(mu + 2048 + ch + 4);
            f32x4 kk0 = *(const GAS f32x4*)(kkp + ch), kk1 = *(const GAS f32x4*)(kkp + ch + 4), ka0 = *(const GAS f32x4*)(kap + ch), ka1 = *(const GAS f32x4*)(kap + ch + 4);
            f32x4 rk0 = *(const GAS f32x4*)(rkp + ch), rk1 = *(const GAS f32x4*)(rkp + ch + 4);
#define HL_LOAD(P, cn_) do { const int tt_ = 32 * (cn_) + t; const size_t tk_ = (size_t)b * T + tt_; \
        P##rc = *(const GAS u32x4*)(RKV + tk_ * 6144 + ch); P##kc = *(const GAS u32x4*)(RKV + tk_ * 6144 + 2048 + ch); \
        if (tt_ > 0) { P##rp = *(const GAS u32x4*)(RKV + (tk_ - 1) * 6144 + ch); P##kp = *(const GAS u32x4*)(RKV + (tk_ - 1) * 6144 + 2048 + ch); } else { P##rp = (u32x4){0u, 0u, 0u, 0u}; P##kp = P##rp; } \
        P##vv = *(const GAS u32x4*)(VS + tk_ * D + ch); P##ag = *(const GAS u32x4*)(AG + tk_ * D + ch); \
        P##d0 = *(const GAS f32x4*)(DEC + tk_ * D + ch); P##d1 = *(const GAS f32x4*)(DEC + tk_ * D + ch + 4); } while (0)
#define H8(x0, x1) (h16x8){(_Float16)x0[0], (_Float16)x0[1], (_Float16)x0[2], (_Float16)x0[3], (_Float16)x1[0], (_Float16)x1[1], (_Float16)x1[2], (_Float16)x1[3]}
#define HL_PROC(P, cn_) do { LAS unsigned char* sb = F.lds + ((cn_) & 1) * SC_BUF; const size_t token = (size_t)b * T + 32 * (cn_) + t; \
        f32x4 r0, r1, k0, k1, v0, v1, a0, a1, p0, p1, q0, q1; unpack8(P##rc, r0, r1); unpack8(P##kc, k0, k1); unpack8(P##rp, p0, p1); unpack8(P##kp, q0, q1); unpack8(P##vv, v0, v1); unpack8(P##ag, a0, a1); \
        const f32x4 d0 = P##d0, d1 = P##d1; \
        r0 = r0 + (p0 - r0) * mr0; r1 = r1 + (p1 - r1) * mr1; k0 = k0 + (q0 - k0) * mk0; k1 = k1 + (q1 - k1) * mk1; \
        f32x4 n0 = k0 * kk0, n1 = k1 * kk1; \
        float ss = (n0[0] * n0[0] + n0[1] * n0[1]) + (n0[2] * n0[2] + n0[3] * n0[3]) + (n1[0] * n1[0] + n1[1] * n1[1]) + (n1[2] * n1[2] + n1[3] * n1[3]); \
        ss = allreduce8(ss); const float inv = 1.0f / sqrtf(fmaxf(ss, 1e-24f)); n0 = n0 * inv; n1 = n1 * inv; \
        const f32x4 k20 = k0 * (1.0f + (a0 - 1.0f) * ka0), k21 = k1 * (1.0f + (a1 - 1.0f) * ka1); \
        float bo = (r0[0] * k20[0] * rk0[0] + r0[1] * k20[1] * rk0[1]) + (r0[2] * k20[2] * rk0[2] + r0[3] * k20[3] * rk0[3]) + (r1[0] * k21[0] * rk1[0] + r1[1] * k21[1] * rk1[1]) + (r1[2] * k21[2] * rk1[2] + r1[3] * k21[3] * rk1[3]); \
        bo = allreduce8(bo); if (half == 0 && cg == 0) BON[token * 32 + h] = bo; \
        { const int ho = (t * 64 + 8 * cg) * 2; const f32x4 wm0 = d0 - 1.0f, wm1 = d1 - 1.0f, na0 = -n0, na1 = -n1, nb0 = n0 * a0, nb1 = n1 * a1; \
          *(LAS h16x8*)(sb + SC_R + ho) = H8(r0, r1); *(LAS h16x8*)(sb + SC_W + ho) = H8(wm0, wm1); *(LAS h16x8*)(sb + SC_K + ho) = H8(k20, k21); \
          *(LAS h16x8*)(sb + SC_A + ho) = H8(na0, na1); *(LAS h16x8*)(sb + SC_B + ho) = H8(nb0, nb1); } \
        if ((cg >> 2) == half) { LAS f32x4* pv = (LAS f32x4*)(sb + SC_V + (t * 32 + 8 * (cg & 3)) * 4); pv[0] = v0; pv[1] = v1; } \
        LDS_WAIT(); SC_BARRIER(); } while (0)
            u32x4 Arc, Arp, Akc, Akp, Avv, Aag, Brc, Brp, Bkc, Bkp, Bvv, Bag; f32x4 Ad0, Ad1, Bd0, Bd1;
            HL_LOAD(A, 0);
            for (int cn = 0; cn < 128; cn += 2) {
                HL_LOAD(B, cn + 1);
                HL_PROC(A, cn);
                if (cn + 2 < 128) HL_LOAD(A, cn + 2);
                HL_PROC(B, cn + 1);
            }
#undef HL_LOAD
#undef HL_PROC
#undef H8
            SC_BARRIER();
        } else {
            const int il = lane >> 3, s_ = lane & 7, rloc = 8 * wave + il, irow = half * 32 + rloc;
            float S[8];
#pragma unroll
            for (int j = 0; j < 8; ++j) S[j] = 0.f;
            const int voff = 16 * s_;
            SC_BARRIER();
#define SC_LOAD(P, t_) do { const int o_ = (t_) * 128 + voff; P##a = *(const LAS u32x4*)(sb + SC_A + o_); P##w = *(const LAS u32x4*)(sb + SC_W + o_); P##b = *(const LAS u32x4*)(sb + SC_B + o_); \
        P##k = *(const LAS u32x4*)(sb + SC_K + o_); P##r = *(const LAS u32x4*)(sb + SC_R + o_); P##v = *(const LAS float*)(sb + SC_V + (t_) * 128 + rloc * 4); } while (0)
#define SC_STEP(P, t_) do { float sa0 = 0.f, sa1 = 0.f; \
        _Pragma("unroll") for (int j = 0; j < 4; ++j) { sa0 = fmix<0>(P##a[j], S[2 * j], sa0); sa1 = fmix<1>(P##a[j], S[2 * j + 1], sa1); } \
        const float sa = allreduce8(sa0 + sa1); \
        _Pragma("unroll") for (int j = 0; j < 4; ++j) { float x0 = fmix<0>(P##w[j], S[2 * j], S[2 * j]), x1 = fmix<1>(P##w[j], S[2 * j + 1], S[2 * j + 1]); \
            x0 = fmix<0>(P##b[j], sa, x0); x1 = fmix<1>(P##b[j], sa, x1); S[2 * j] = fmix<0>(P##k[j], P##v, x0); S[2 * j + 1] = fmix<1>(P##k[j], P##v, x1); } \
        float y0 = 0.f, y1 = 0.f; \
        _Pragma("unroll") for (int j = 0; j < 4; ++j) { y0 = fmix<0>(P##r[j], S[2 * j], y0); y1 = fmix<1>(P##r[j], S[2 * j + 1], y1); } \
        const float y = allreduce8(y0 + y1); if (s_ == 0) yp[(size_t)(t_) * D] = y; } while (0)
            for (int c = 0; c < 128; ++c) {
                const LAS unsigned char* sb = F.lds + (c & 1) * SC_BUF;
                float* yp = YR + ((size_t)b * T + 32 * c) * D + h * 64 + irow;
                u32x4 Aa, Aw, Ab, Ak, Ar, Ba, Bw, Bb, Bk, Br; float Av, Bv;
                SC_LOAD(A, 0);
                for (int t = 0; t < 32; t += 2) {
                    SC_LOAD(B, t + 1);
                    SC_STEP(A, t);
                    if (t + 2 < 32) SC_LOAD(A, t + 2);
                    SC_STEP(B, t + 1);
                }
                SC_BARRIER();
            }
#undef SC_LOAD
#undef SC_STEP
        }
    }
}
__device__ __forceinline__ float wave_sum_u(float v) {
    v += dpp<0xB1>(v); v += dpp<0x4E>(v); v += dpp<0x141>(v); v += dpp<0x140>(v);
    v += __builtin_bit_cast(float, __builtin_amdgcn_update_dpp(0, __builtin_bit_cast(int, v), 0x142, 0xa, 0xf, false));
    v += __builtin_bit_cast(float, __builtin_amdgcn_update_dpp(0, __builtin_bit_cast(int, v), 0x143, 0xc, 0xf, false));
    return __builtin_bit_cast(float, __builtin_amdgcn_readlane(__builtin_bit_cast(int, v), 63));
}
constexpr int CK_XA = 0, CK_XR = 2304, CK_XB = 4608, CK_XK = 6912, CK_AT = 9216, CK_VT = 11264, CK_TB = 13312, CK_GC = 13824, CK_WAVE = 14336, CK_STATE = 8 * CK_WAVE;
static_assert(CK_STATE + 16384 <= RING_BYTES, "chunked-scan LDS");
__device__ __forceinline__ u32x2 pk4(const f32x4 v) { u32x2 r; r.x = pk2h(v[0], v[1]); r.y = pk2h(v[2], v[3]); return r; }
__device__ __forceinline__ bf16x8 frag2(const u32x2 lo, const u32x2 hi) { const u32x4 w = (u32x4){lo.x, lo.y, hi.x, hi.y}; return __builtin_bit_cast(bf16x8, w); }
__device__ __forceinline__ bf16x8 frag1(const u32x2 lo) { const u32x4 w = (u32x4){lo.x, lo.y, 0u, 0u}; return __builtin_bit_cast(bf16x8, w); }
#define MFMA16(a, b, c) __builtin_amdgcn_mfma_f32_16x16x32_bf16(a, b, c, 0, 0, 0)
__device__ __forceinline__ void phase_scan_chunked(int wv, int l) {
    const Frame F = mkframe(wv); unsigned char* ws = wsptr(F); const int lane = F.lane, wave = F.wave, fr0 = lane & 15, fq0 = lane >> 4;
    const bf16* RKV = (const bf16*)(ws + WS_RKV); const bf16* VS = (const bf16*)(ws + (l ? WS_VS1 : WS_VS0)); const float* DEC = (const float*)(ws + WS_DEC); const bf16* AG = (const bf16*)(ws + WS_AG);
    float* YR = (float*)(ws + WS_YR); float* BON = (float*)(ws + WS_BON);
    const float* mu = inptr(F, 2) + (size_t)l * 6592; const float* kkp = inptr(F, 11) + (size_t)l * D; const float* kap = inptr(F, 12) + (size_t)l * D; const float* rkp = inptr(F, 13) + (size_t)l * D;
    LAS unsigned char* P = F.lds + wave * CK_WAVE;
    LAS unsigned char* STB = F.lds + CK_STATE;
    volatile LAS int* flag = (volatile LAS int*)(F.lds + MISC_OFF + 64);
    for (int uid = F.bx; uid < 128; uid += F.G) {
        const int b = uid >> 5, h = uid & 31, ch = h * 64 + lane;
        if (F.tid == 0) *flag = 0;
        for (int e = F.tid; e < 4096; e += NTHR) ((LAS float*)STB)[e] = 0.f;
        SC_BARRIER();
        const float mur = mu[ch], muk = mu[2048 + ch], kkj = kkp[ch], kaj = kap[ch], rkj = rkp[ch];
        unsigned short qr[16], qk[16], qv[16], qa[16], qrp = 0, qkp = 0; float qd[16];
#define CK_LOAD(t0_, hasprev_) do { const size_t t0__ = (t0_); _Pragma("unroll") for (int t = 0; t < 16; ++t) { const size_t tk = t0__ + t; qr[t] = RKV[tk * 6144 + ch]; qk[t] = RKV[tk * 6144 + 2048 + ch]; \
            qv[t] = VS[tk * D + ch]; qa[t] = AG[tk * D + ch]; qd[t] = DEC[tk * D + ch]; } \
        if (hasprev_) { qrp = RKV[(t0__ - 1) * 6144 + ch]; qkp = RKV[(t0__ - 1) * 6144 + 2048 + ch]; } } while (0)
        CK_LOAD((size_t)b * T + 16 * wave, wave > 0);
        for (int c = wave; c < 256; c += 8) {
            const size_t tok0 = (size_t)b * T + 16 * c;
            int fr = fr0, fq = fq0; asm volatile("" : "+v"(fr), "+v"(fq));
            float rr[16], kr[16], vv[16], ga[16], dc[16];
#pragma unroll
            for (int t = 0; t < 16; ++t) { rr[t] = bf2f(qr[t]); kr[t] = bf2f(qk[t]); vv[t] = bf2f(qv[t]); ga[t] = bf2f(qa[t]); dc[t] = qd[t]; }
            const float rp = bf2f(qrp), kp = bf2f(qkp);
            float G = 1.0f; float bh[16], kh[16];
            { u32x4 vt0, vt1; unsigned vw[8];
#pragma unroll
              for (int t = 0; t < 16; t += 2) vw[t >> 1] = pk2h(vv[t], vv[t + 1]);
              vt0 = (u32x4){vw[0], vw[1], vw[2], vw[3]}; vt1 = (u32x4){vw[4], vw[5], vw[6], vw[7]};
              *(LAS u32x4*)(P + CK_VT + lane * 32) = vt0; *(LAS u32x4*)(P + CK_VT + lane * 32 + 16) = vt1; }
            unsigned atw[8]; float atprev = 0.f;
#pragma unroll
            for (int t = 0; t < 16; ++t) {
                const float rs = rr[t] + ((t ? rr[t - 1] : rp) - rr[t]) * mur, ks = kr[t] + ((t ? kr[t - 1] : kp) - kr[t]) * muk;
                const float kk = ks * kkj; const float ss = wave_sum_u(kk * kk); const float kn = kk * __builtin_amdgcn_rsqf(fmaxf(ss, 1e-24f));
                const float k2 = ks * (1.0f + (ga[t] - 1.0f) * kaj);
                const float bo = wave_sum_u(rs * k2 * rkj); if (lane == 0) BON[(tok0 + t) * 32 + h] = bo;
                const float Gp = G; G *= dc[t]; const float iG = __builtin_amdgcn_rcpf(G);
                const float at = -kn * Gp, rt = rs * G; bh[t] = kn * ga[t] * iG; kh[t] = k2 * iG;
                *(LAS unsigned short*)(P + CK_XA + t * 144 + lane * 2) = (unsigned short)pk2h(at, at);
                *(LAS unsigned short*)(P + CK_XR + t * 144 + lane * 2) = (unsigned short)pk2h(rt, rt);
                *(LAS unsigned short*)(P + CK_XB + t * 144 + lane * 2) = (unsigned short)pk2h(bh[t], bh[t]);
                *(LAS unsigned short*)(P + CK_XK + t * 144 + lane * 2) = (unsigned short)pk2h(kh[t], kh[t]);
                if (t & 1) atw[t >> 1] = pk2h(atprev, at); atprev = at;
            }
            *(LAS u32x4*)(P + CK_AT + lane * 32) = (u32x4){atw[0], atw[1], atw[2], atw[3]}; *(LAS u32x4*)(P + CK_AT + lane * 32 + 16) = (u32x4){atw[4], atw[5], atw[6], atw[7]};
            *(LAS float*)(P + CK_GC + lane * 4) = G;
            LDS_WAIT(); asm volatile("" ::: "memory");
            const f32x4 Z4 = (f32x4){0.f, 0.f, 0.f, 0.f};
            f32x4 m1 = Z4, m2t = Z4, m3t = Z4, m4t = Z4;
#pragma unroll
            for (int ks = 0; ks < 2; ++ks) { const int o = fr * 144 + (32 * ks + 8 * fq) * 2;
                const bf16x8 fa = *(const LAS bf16x8*)(P + CK_XA + o), frr = *(const LAS bf16x8*)(P + CK_XR + o), fb = *(const LAS bf16x8*)(P + CK_XB + o), fk = *(const LAS bf16x8*)(P + CK_XK + o);
                m1 = MFMA16(fa, fb, m1);
                m2t = MFMA16(fk, fa, m2t);
                m3t = MFMA16(fb, frr, m3t);
                m4t = MFMA16(fk, frr, m4t); }
#pragma unroll
            for (int r = 0; r < 4; ++r) { const int q = 4 * fq + r; if (!(fr < q)) m1[r] = 0.f; if (!(q < fr)) m2t[r] = 0.f; if (!(q <= fr)) { m3t[r] = 0.f; m4t[r] = 0.f; } }
            float Tr[16]; const int cc = fr;
            int m1r[4];
#pragma unroll
            for (int r = 0; r < 4; ++r) { const float e_ = m1[r]; m1r[r] = __builtin_bit_cast(int, e_); }
#pragma unroll
            for (int t = 0; t < 16; ++t) { float acc = (cc == t) ? 1.0f : 0.f;
#pragma unroll
                for (int s2 = 0; s2 < t; ++s2) { const float m = __builtin_bit_cast(float, __builtin_amdgcn_readlane(m1r[t & 3], (t >> 2) * 16 + s2)); acc = __builtin_fmaf(m, Tr[s2], acc); }
                Tr[t] = acc; __builtin_amdgcn_sched_barrier(0); }
            if (lane < 16) {
#pragma unroll
                for (int t = 0; t < 16; ++t) *(LAS unsigned short*)(P + CK_TB + t * 32 + lane * 2) = (unsigned short)pk2h(Tr[t], Tr[t]); }
            { unsigned bw[8], kw[8];
#pragma unroll
              for (int t = 0; t < 16; t += 2) { bw[t >> 1] = pk2h(bh[t] * G, bh[t + 1] * G); kw[t >> 1] = pk2h(kh[t] * G, kh[t + 1] * G); }
              LDS_WAIT(); asm volatile("" ::: "memory");
              *(LAS u32x4*)(P + CK_XB + lane * 32) = (u32x4){bw[0], bw[1], bw[2], bw[3]}; *(LAS u32x4*)(P + CK_XB + lane * 32 + 16) = (u32x4){bw[4], bw[5], bw[6], bw[7]};
              *(LAS u32x4*)(P + CK_XK + lane * 32) = (u32x4){kw[0], kw[1], kw[2], kw[3]}; *(LAS u32x4*)(P + CK_XK + lane * 32 + 16) = (u32x4){kw[4], kw[5], kw[6], kw[7]}; }
            LDS_WAIT(); asm volatile("" ::: "memory");
            const bf16x8 Tf = frag1(*(const LAS u32x2*)(P + CK_TB + fr * 32 + 8 * fq));
            const bf16x8 M2f = frag1(pk4(m2t)), M34f = frag2(pk4(m3t), pk4(m4t)), M3f = frag1(pk4(m3t));
#pragma unroll
            for (int jt = 0; jt < 4; ++jt) {
                const bf16x8 atf = frag1(*(const LAS u32x2*)(P + CK_AT + (16 * jt + fr) * 32 + 8 * fq));
                const f32x4 ah = MFMA16(Tf, atf, Z4);
                const f32x4 aht = MFMA16(atf, Tf, Z4);
                LAS u32x2* rq = (LAS u32x2*)(P + CK_XR + fr * 144 + (16 * jt + 4 * fq) * 2);
                const u32x2 rw = *rq; const f32x4 rinit = (f32x4){bflo(rw.x), bfhi(rw.x), bflo(rw.y), bfhi(rw.y)};
                const f32x4 rht = MFMA16(frag1(pk4(ah)), M3f, rinit);
                *(LAS u32x2*)(P + CK_XA + fr * 144 + (16 * jt + 4 * fq) * 2) = pk4(aht);
                *rq = pk4(rht); }
            f32x4 W2[4], Y0[4]; u32x2 vtf[4];
#pragma unroll
            for (int it = 0; it < 4; ++it) { vtf[it] = *(const LAS u32x2*)(P + CK_VT + (16 * it + fr) * 32 + 8 * fq);
                const f32x4 x = MFMA16(M2f, frag1(vtf[it]), Z4);
                W2[it] = MFMA16(Tf, frag1(pk4(x)), Z4);
                Y0[it] = MFMA16(M34f, frag2(pk4(W2[it]), vtf[it]), Z4); }
            LDS_WAIT(); asm volatile("" ::: "memory");
            { int spins = 0; while (*flag < c) { if (++spins > (1 << 27)) break; } }
            asm volatile("" ::: "memory");
            __builtin_amdgcn_s_setprio(3);
            f32x4 St[4][4];
#pragma unroll
            for (int jt = 0; jt < 4; ++jt)
#pragma unroll
                for (int it = 0; it < 4; ++it) St[jt][it] = *(const LAS f32x4*)(STB + (jt * 4 + it) * 1024 + lane * 16);
            f32x4 U[4]; bf16x8 sb[2][4];
#pragma unroll
            for (int it = 0; it < 4; ++it) { U[it] = W2[it];
#pragma unroll
                for (int ks = 0; ks < 2; ++ks) sb[ks][it] = frag2(pk4(St[2 * ks][it]), pk4(St[2 * ks + 1][it])); }
#pragma unroll
            for (int ks = 0; ks < 2; ++ks) {
                const bf16x8 af = frag2(*(const LAS u32x2*)(P + CK_XA + fr * 144 + (32 * ks + 4 * fq) * 2), *(const LAS u32x2*)(P + CK_XA + fr * 144 + (32 * ks + 16 + 4 * fq) * 2));
#pragma unroll
                for (int it = 0; it < 4; ++it) U[it] = MFMA16(af, sb[ks][it], U[it]); }
#pragma unroll
            for (int jt = 0; jt < 4; ++jt) {
                const bf16x8 bkf = frag2(*(const LAS u32x2*)(P + CK_XB + (16 * jt + fr) * 32 + 8 * fq), *(const LAS u32x2*)(P + CK_XK + (16 * jt + fr) * 32 + 8 * fq));
                const f32x4 gc = *(const LAS f32x4*)(P + CK_GC + (16 * jt + 4 * fq) * 4);
#pragma unroll
                for (int it = 0; it < 4; ++it) { const f32x4 sn = MFMA16(bkf, frag2(pk4(U[it]), vtf[it]), St[jt][it] * gc);
                    *(LAS f32x4*)(STB + (jt * 4 + it) * 1024 + lane * 16) = sn; } }
            LDS_WAIT(); asm volatile("" ::: "memory");
            if (lane == 0) *flag = c + 1;
            asm volatile("" ::: "memory");
            __builtin_amdgcn_s_setprio(0);
            CK_LOAD((c + 8 < 256) ? tok0 + 128 : tok0, true);
            f32x4 Yv[4];
#pragma unroll
            for (int it = 0; it < 4; ++it) Yv[it] = Y0[it];
#pragma unroll
            for (int ks = 0; ks < 2; ++ks) {
                const bf16x8 rf = frag2(*(const LAS u32x2*)(P + CK_XR + fr * 144 + (32 * ks + 4 * fq) * 2), *(const LAS u32x2*)(P + CK_XR + fr * 144 + (32 * ks + 16 + 4 * fq) * 2));
#pragma unroll
                for (int it = 0; it < 4; ++it) Yv[it] = MFMA16(rf, sb[ks][it], Yv[it]); }
#pragma unroll
            for (int it = 0; it < 4; ++it)
#pragma unroll
                for (int r = 0; r < 4; ++r) { const float yv_ = Yv[it][r]; ((GAS unsigned short*)YR)[(tok0 + 4 * fq + r) * D + h * 64 + 16 * it + fr] = (unsigned short)pk2h(yv_, yv_); }
        }
#undef CK_LOAD
        SC_BARRIER();
    }
}

__device__ __forceinline__ float row_sum16(float v) { v += dpp<0xB1>(v); v += dpp<0x4E>(v); v += dpp<0x141>(v); v += dpp<0x140>(v); return v; }
__device__ __forceinline__ void phase_rw_e3(int wv, int l) {
    const Frame F = mkframe(wv); unsigned char* ws = wsptr(F); const int lane = F.lane;
    const float* YR = (const float*)(ws + WS_YR); const float* BON = (const float*)(ws + WS_BON); const bf16* VS = (const bf16*)(ws + (l ? WS_VS1 : WS_VS0)); const bf16* GG = (const bf16*)(ws + WS_GG); bf16* YRW = (bf16*)(ws + WS_YRW);
    const float* gng = inptr(F, 14) + (size_t)l * D; const float* gnb = inptr(F, 15) + (size_t)l * D;
    const int NGW = F.G * NWAVES;
    for (int row0 = F.vcu * NWAVES + F.wave; row0 < M; row0 += 2 * NGW) {
        f32x4 y[2][8];
#pragma unroll
        for (int r = 0; r < 2; ++r) { const int row = min(row0 + r * NGW, M - 1);
#pragma unroll
            for (int j = 0; j < 8; ++j) { const u32x2 yr_ = ((const GAS u32x2*)((const bf16*)YR + (size_t)row * D))[64 * j + lane]; y[r][j] = (f32x4){bflo(yr_.x), bfhi(yr_.x), bflo(yr_.y), bfhi(yr_.y)}; } }
#pragma unroll
        for (int r = 0; r < 2; ++r) { const int row = row0 + r * NGW; if (row >= M) break;
#pragma unroll
            for (int j = 0; j < 8; ++j) {
                const u32x2 vr = ((const GAS u32x2*)(VS + (size_t)row * D))[64 * j + lane], gr = ((const GAS u32x2*)(GG + (size_t)row * D))[64 * j + lane];
                const f32x4 w = ((const GAS f32x4*)gng)[64 * j + lane], bb = ((const GAS f32x4*)gnb)[64 * j + lane];
                const float bo = BON[(size_t)row * 32 + 4 * j + (lane >> 4)];
                f32x4 t = y[r][j];
                const float mean = row_sum16((t[0] + t[1]) + (t[2] + t[3])) * (1.f / 64.f);
                t = t - mean;
                const float rstd = 1.0f / sqrtf(row_sum16((t[0] * t[0] + t[1] * t[1]) + (t[2] * t[2] + t[3] * t[3])) * (1.f / 64.f) + 64e-5f);
                const f32x4 v = (f32x4){bflo(vr.x), bfhi(vr.x), bflo(vr.y), bfhi(vr.y)}, g = (f32x4){bflo(gr.x), bfhi(gr.x), bflo(gr.y), bfhi(gr.y)};
                const f32x4 o = (t * rstd * w + bb + v * bo) * g;
                u32x2 ov; ov.x = pk2(o[0], o[1]); ov.y = pk2(o[2], o[3]);
                ((GAS u32x2*)(YRW + (size_t)row * D))[64 * j + lane] = ov; }
        }
    }
}

__device__ __forceinline__ void grid_bar(int wv) { const Frame F = mkframe(wv); xcd_barrier_impl((unsigned*)(wsptr(F) + WS_CTL) + CW_BAR, (volatile LAS unsigned*)(F.lds + MISC_OFF) + 8); }
#define SITE_BEGIN const Frame F = mkframe(wv); unsigned char* ws = wsptr(F); pg8::StaticOrder S;
__device__ __forceinline__ void site_ffn_up(int wv, int f) { SITE_BEGIN
    pg8::Gemm g{(const bf16*)(ws + WS_XB), (const bf16*)(ws + (f ? WS_W2U : WS_W1U)), M, 2 * FF, D, D, D}; S.init(M, 2 * FF, F.G, F.bx);
    EpiSwiGLU E{(bf16*)(ws + WS_H)}; pg8::gemm_phase<EpiSwiGLU>(F.lds, g, S, E, F.wave, F.lane); }
template <int F_, int L_> __device__ __forceinline__ void site_ffn_down(int wv) { SITE_BEGIN
    constexpr int f = F_;
    pg8::Gemm g{(const bf16*)(ws + WS_H), (const bf16*)(ws + (f ? WS_W2D : WS_W1D)), M, D, FF, FF, FF}; S.init(M, D, F.G, F.bx);
    constexpr int prev = L_ * 3 + (F_ ? 1 : -1);
    if constexpr (prev >= 0) { float* Xp = outptr(F); EpiResid<true> E{Xp, Xp, 0.5f, (const float*)(ws + WS_LNS), inptr(F, 34) + (size_t)prev * D, inptr(F, 35) + (size_t)prev * D}; pg8::gemm_phase<EpiResid<true>>(F.lds, g, S, E, F.wave, F.lane); }
    else { EpiResid<false> E{outptr(F), inptr(F, 0), 0.5f, nullptr, nullptr, nullptr}; pg8::gemm_phase<EpiResid<false>>(F.lds, g, S, E, F.wave, F.lane); } }
__device__ __forceinline__ void site_inA(int wv) { SITE_BEGIN
    pg8::Gemm g{(const bf16*)(ws + WS_XB), (const bf16*)(ws + WS_WIN), M, 10496, D, D, D}; S.init(M, 10496, F.G, F.bx);
    EpiInA E{(float*)(ws + WS_LG), (bf16*)(ws + WS_GU), (bf16*)(ws + WS_QB), (bf16*)(ws + WS_K3), (bf16*)(ws + WS_VC)}; pg8::gemm_phase<EpiInA>(F.lds, g, S, E, F.wave, F.lane); }
__device__ __forceinline__ void site_vt(int wv) { SITE_BEGIN
    pg8::Gemm g{(const bf16*)(ws + WS_WIN) + (size_t)10496 * D, (const bf16*)(ws + WS_XB), 1024, M, D, D, D}; S.init(1024, M, F.G, F.bx);
    EpiBf16 E{(bf16*)(ws + WS_VT), M, M, 1024}; pg8::gemm_phase<EpiBf16>(F.lds, g, S, E, F.wave, F.lane); }
__device__ __forceinline__ void site_cmp1(int wv, int l) { SITE_BEGIN
    { pg8::Gemm g{(const bf16*)(ws + WS_K3), (const bf16*)(ws + WS_PK1), 4096, 256, 6144, 3072, 6144}; S.init(4096, 256, F.G, F.bx);
      EpiCmp1 E{(bf16*)(ws + WS_HK), (const float*)(ws + WS_B1) + l * 512}; pg8::gemm_phase<EpiCmp1>(F.lds, g, S, E, F.wave, F.lane); }
    { const int bx2 = (F.bx + F.G - 16) % F.G;
      pg8::Gemm g{(const bf16*)(ws + WS_VC), (const bf16*)(ws + WS_PV1), 4096, 256, 4096, 2048, 4096}; S.init(4096, 256, F.G, bx2);
      EpiCmp1 E{(bf16*)(ws + WS_HV), (const float*)(ws + WS_B1) + l * 512 + 256}; pg8::gemm_phase<EpiCmp1>(F.lds, g, S, E, F.wave, F.lane); } }
__device__ __forceinline__ void site_cmp2(int wv) { SITE_BEGIN
    { pg8::Gemm g{(const bf16*)(ws + WS_HK), (const bf16*)(ws + WS_PK2), 4096, 256, 256, 256, 256}; S.init(4096, 256, F.G, F.bx);
      EpiBf16 E{(bf16*)(ws + WS_KCMP), 192, 192, 4096}; pg8::gemm_phase<EpiBf16>(F.lds, g, S, E, F.wave, F.lane); }
    { const int bx2 = (F.bx + 128) % F.G;
      pg8::Gemm g{(const bf16*)(ws + WS_PV2), (const bf16*)(ws + WS_HV), 256, 4096, 256, 256, 256}; S.init(256, 4096, F.G, bx2);
      EpiBf16 E{(bf16*)(ws + WS_VCMT), 4096, 4096, 128}; pg8::gemm_phase<EpiBf16>(F.lds, g, S, E, F.wave, F.lane); } }
__device__ __forceinline__ void site_rkv(int wv) { SITE_BEGIN
    pg8::Gemm g{(const bf16*)(ws + WS_XB), (const bf16*)(ws + WS_WIN) + (size_t)11520 * D, M, 6144, D, D, D}; S.init(M, 6144, F.G, F.bx);
    EpiBf16 E{(bf16*)(ws + WS_RKV), 6144, 6144, M}; pg8::gemm_phase<EpiBf16>(F.lds, g, S, E, F.wave, F.lane); }
__device__ __forceinline__ void site_lora_wa(int wv, int l) { SITE_BEGIN
    pg8::Gemm g{(const bf16*)(ws + WS_AL), (const bf16*)(ws + WS_LWA), M, 4096, 256, 512, 256}; S.init(M, 4096, F.G, F.bx);
    EpiLoraWA E{(float*)(ws + WS_DEC), (bf16*)(ws + WS_AG), inptr(F, 3) + (size_t)l * D, inptr(F, 5) + (size_t)l * D}; pg8::gemm_phase<EpiLoraWA>(F.lds, g, S, E, F.wave, F.lane); }
__device__ __forceinline__ void site_lora_g(int wv) { SITE_BEGIN
    pg8::Gemm g{(const bf16*)(ws + WS_AL) + 256, (const bf16*)(ws + WS_LG2), M, 2048, 256, 512, 256}; S.init(M, 2048, F.G, F.bx);
    EpiBf16 E{(bf16*)(ws + WS_GG), D, D, M}; pg8::gemm_phase<EpiBf16>(F.lds, g, S, E, F.wave, F.lane); }
__device__ __forceinline__ void site_lora_vl(int wv) { SITE_BEGIN
    const int p = (F.bx * 4) / F.G, nb = F.G / 4;
    pg8::Gemm g{(const bf16*)(ws + WS_VS1) + 512 * p, (const bf16*)(ws + WS_LV1) + 512 * p, M, 256, 512, D, D}; S.init(M, 256, nb, F.bx - p * nb);
    EpiBf16Quarter E{(bf16*)(ws + WS_VL), 256, p}; pg8::gemm_phase<EpiBf16Quarter>(F.lds, g, S, E, F.wave, F.lane); }
__device__ __forceinline__ void site_vmix(int wv) { SITE_BEGIN
    pg8::Gemm g{(const bf16*)(ws + WS_VL), (const bf16*)(ws + WS_LV2), M, 2048, 256, 256, 256}; S.init(M, 2048, F.G, F.bx);
    EpiVmix E{(bf16*)(ws + WS_VS1), (const bf16*)(ws + WS_VS0), inptr(F, 8)}; pg8::gemm_phase<EpiVmix>(F.lds, g, S, E, F.wave, F.lane); }
__device__ __forceinline__ void site_gate(int wv, int t0, int nt, int b0, int nb) { SITE_BEGIN
    if (F.bx < b0 || F.bx >= b0 + nb) return;
    S.init(M, nt * 256, nb, F.bx - b0);
    pg8::Gemm g{(const bf16*)(ws + WS_XB), (const bf16*)(ws + WS_WIN) + (size_t)(17664 + t0 * 256) * D, M, nt * 256, D, D, D};
    EpiSigmoid E{(bf16*)(ws + WS_G) + t0 * 256, 6144}; pg8::gemm_phase<EpiSigmoid>(F.lds, g, S, E, F.wave, F.lane); }
template <int I> __device__ __forceinline__ void site_merge(int wv) { SITE_BEGIN
    pg8::Gemm g{(const bf16*)(ws + (I == 0 ? WS_YRW : I == 1 ? WS_YGM : WS_YNS)), (const bf16*)(ws + WS_WBR + I * SZ_DD), M, D, D, D, D}; S.init(M, D, F.G, F.bx);
    EpiMerge<I> E{(float*)(ws + WS_M32), (bf16*)(ws + WS_MB), (const bf16*)(ws + WS_G) + I * 2048}; pg8::gemm_phase<EpiMerge<I>>(F.lds, g, S, E, F.wave, F.lane); }
__device__ __forceinline__ void site_wo(int wv, int l) { SITE_BEGIN
    pg8::Gemm g{(const bf16*)(ws + WS_MB), (const bf16*)(ws + WS_WO), M, D, D, D, D}; S.init(M, D, F.G, F.bx);
    float* Xp = outptr(F); EpiResid<true> E{Xp, Xp, 1.0f, (const float*)(ws + WS_LNS), inptr(F, 34) + (size_t)(l * 3) * D, inptr(F, 35) + (size_t)(l * 3) * D};
    pg8::gemm_phase<EpiResid<true>>(F.lds, g, S, E, F.wave, F.lane); }

template <int F_, int L_> __device__ __forceinline__ void ffn_body(int wv) {
    constexpr int l = L_;
    site_ffn_up(wv, F_);
    grid_bar(wv);
    site_ffn_down<F_, L_>(wv);
    grid_bar(wv);
    phase_ln(wv, l, F_ ? 2 : 0);
    if (!(F_ == 1 && L_ + 1 < DEPTH)) grid_bar(wv);
}
template <int L_> __device__ __forceinline__ void layer_body(int wv) {
    constexpr int l = L_;
    phase_convert(wv, l);
    phase_convert_small(wv, l);
    grid_bar(wv);
    ffn_body<0, L_>(wv);
    site_inA(wv); site_vt(wv); site_rkv(wv);
    grid_bar(wv);
    phase_gm_stats(wv); site_cmp1(wv, l); site_gate(wv, 0, 10, 32, 224);
    grid_bar(wv);
    phase_gmlp(wv, l); site_cmp2(wv);
    grid_bar(wv);
    phase_nsa_attn(wv); phase_rw_e1(wv, l);
    grid_bar(wv);
    site_lora_wa(wv, l); site_lora_g(wv); if (l > 0) site_lora_vl(wv);
    grid_bar(wv);
    if (l > 0) { site_vmix(wv); grid_bar(wv); }
    phase_scan_chunked(wv, l); site_gate(wv, 10, 14, 128, 128);
    grid_bar(wv);
    phase_rw_e3(wv, l);
    grid_bar(wv);
    site_merge<0>(wv); site_merge<1>(wv); site_merge<2>(wv);
    grid_bar(wv);
    site_wo(wv, l);
    grid_bar(wv);
    phase_ln(wv, l, 1);
    grid_bar(wv);
    ffn_body<1, L_>(wv);
}
__global__ void __launch_bounds__(NTHR, 2) mk_fwd(Args args) {
    extern __shared__ __attribute__((aligned(16))) unsigned char lds_raw[];
    {
        LAS unsigned char* lds = (LAS unsigned char*)lds_raw;
        for (int u = threadIdx.x; u < (LDS_BYTES - LDSCTL_OFF) / 4; u += NTHR) ((LAS unsigned*)(lds + LDSCTL_OFF))[u] = 0u;
        __syncthreads();
        if (threadIdx.x < 38) ((LAS unsigned long long*)(lds + PTAB_OFF))[threadIdx.x] = ((const unsigned long long*)&args)[threadIdx.x];
        __syncthreads();
    }
    const int wv = __builtin_amdgcn_readfirstlane(threadIdx.x >> 6);
    { const Frame F = mkframe(wv); xcd_barrier_post((unsigned*)(wsptr(F) + WS_CTL) + CW_BAR); }
#define GRID_BAR() grid_bar(wv)

    layer_body<0>(wv);
    layer_body<1>(wv);
}

extern "C" void kernel_launch(void* const* d_in, const int* in_sizes, int n_in, void* d_out, int out_size, void* d_ws, size_t ws_size, hipStream_t stream) {
    static int grid = 0;
    if (grid == 0) {
        if (n_in != 36 || out_size != M * D || ws_size < WS_END) { fprintf(stderr, "kernel_launch: unexpected shapes n_in %d out %d ws %zu (need %zu)\n", n_in, out_size, ws_size, (size_t)WS_END); grid = -1; return; }
        int dev = 0, cus = 0, per_cu = 0;
        if (hipGetDevice(&dev) != hipSuccess || hipDeviceGetAttribute(&cus, hipDeviceAttributeMultiprocessorCount, dev) != hipSuccess) { grid = -1; return; }
        if (hipFuncSetAttribute((const void*)mk_fwd, hipFuncAttributeMaxDynamicSharedMemorySize, LDS_BYTES) != hipSuccess) { fprintf(stderr, "kernel_launch: hipFuncSetAttribute failed\n"); grid = -1; return; }
        if (hipOccupancyMaxActiveBlocksPerMultiprocessor(&per_cu, (const void*)mk_fwd, NTHR, LDS_BYTES) != hipSuccess || per_cu < 1) fprintf(stderr, "kernel_launch: occupancy query says %d\n", per_cu);
        (void)hipGetLastError();
        grid = cus;
    }
    if (grid < 0) return;
    if (hipMemsetAsync((char*)d_ws + WS_CTL, 0, CTL_ZERO_BYTES, stream) != hipSuccess) return;
    Args a{};
    for (int i = 0; i < 36; ++i) a.in[i] = (const float*)d_in[i];
    a.out = (float*)d_out; a.ws = (unsigned char*)d_ws;
    hipLaunchKernelGGL(mk_fwd, dim3(grid), dim3(NTHR), LDS_BYTES, stream, a);
}
```
